# Optimizing an MI355X kernel written in HIP

```python
import math
import jax, jax.numpy as jnp
from jax import lax
import numpy as np

D_MODEL = 1024
BATCH = 16
SEQ = 2048
DEPTH = 2

N_A_LAYERS = DEPTH // 2
N_B_LAYERS = DEPTH - N_A_LAYERS
N_DENSE_FFN = (DEPTH + 1) // 2
N_MOE_FFN = DEPTH // 2

S5_GROUP = 16
S5_GROUPS = D_MODEL // S5_GROUP
S5_STATE = 64
S5_DT_MIN = 1e-3
S5_DT_MAX = 1e-1

MLA_HEADS = 8
QK_NOPE = 128
QK_ROPE = 64
V_DIM = 128
Q_LORA = 256
KV_LORA = 128
ROPE_THETA = 10000.0
Q_BLOCK = 128

FFN_DIM = 2816
N_EXPERTS = 8
TOP_K = 2
EXPERT_DIM = 3584
ROUTE_BLOCK = 128

ALPHA = (2.0 * DEPTH) ** 0.25
BETA = (8.0 * DEPTH) ** -0.25
LN_EPS = 1e-5
RMS_EPS = 1e-6

kernel_name = 'yoco_s5_mla_moe_deepnorm'


def _layer_norm(x, g, b):
    xf = x.astype(jnp.float32)
    mu = jnp.mean(xf, axis=-1, keepdims=True)
    var = jnp.mean(jnp.square(xf - mu), axis=-1, keepdims=True)
    y = (xf - mu) * lax.rsqrt(var + LN_EPS) * g.astype(jnp.float32) + b.astype(jnp.float32)
    return y.astype(x.dtype)


def _rms_norm(x, g):
    xf = x.astype(jnp.float32)
    y = xf * lax.rsqrt(jnp.mean(jnp.square(xf), axis=-1, keepdims=True) + RMS_EPS) * g.astype(jnp.float32)
    return y.astype(x.dtype)


def _rope_tables(seq_len):
    pos = jnp.arange(seq_len, dtype=jnp.float32)
    inv_freq = ROPE_THETA ** (-jnp.arange(0, QK_ROPE, 2, dtype=jnp.float32) / QK_ROPE)
    ang = pos[:, None] * inv_freq[None, :]
    return jnp.cos(ang), jnp.sin(ang)


def _apply_rope(t, cos, sin):
    half = t.shape[-1] // 2
    t1 = t[..., :half].astype(jnp.float32)
    t2 = t[..., half:].astype(jnp.float32)
    out = jnp.concatenate([t1 * cos - t2 * sin, t1 * sin + t2 * cos], axis=-1)
    return out.astype(t.dtype)


def _s5_combine(left, right):
    a_re_l, a_im_l, b_re_l, b_im_l = left
    a_re_r, a_im_r, b_re_r, b_im_r = right
    return (a_re_r * a_re_l - a_im_r * a_im_l,
            a_re_r * a_im_l + a_im_r * a_re_l,
            a_re_r * b_re_l - a_im_r * b_im_l + b_re_r,
            a_re_r * b_im_l + a_im_r * b_re_l + b_im_r)


def _s5_mixer(u, lam_re, lam_im, log_step, b_re, b_im, c_re, c_im, d_skip, w_glu):
    bsz, seq, _ = u.shape
    f32 = jnp.float32
    uf = u.astype(f32)
    lr = lam_re.astype(f32)
    li = lam_im.astype(f32)
    dt = jnp.exp(log_step.astype(f32))[:, None]
    mag = jnp.exp(lr * dt)
    lb_re = mag * jnp.cos(li * dt)
    lb_im = mag * jnp.sin(li * dt)
    den = lr * lr + li * li
    f_re = ((lb_re - 1.0) * lr + lb_im * li) / den
    f_im = (lb_im * lr - (lb_re - 1.0) * li) / den
    br = b_re.astype(f32)
    bi = b_im.astype(f32)
    bb_re = f_re[..., None] * br - f_im[..., None] * bi
    bb_im = f_re[..., None] * bi + f_im[..., None] * br
    ug = uf.reshape(bsz, seq, S5_GROUPS, S5_GROUP)
    bu_re = jnp.einsum('bsgc,gpc->sbgp', ug, bb_re)
    bu_im = jnp.einsum('bsgc,gpc->sbgp', ug, bb_im)
    a_re = jnp.broadcast_to(lb_re, (seq, 1) + lb_re.shape)
    a_im = jnp.broadcast_to(lb_im, (seq, 1) + lb_im.shape)
    _, _, s_re, s_im = lax.associative_scan(_s5_combine, (a_re, a_im, bu_re, bu_im), axis=0)
    y = (jnp.einsum('sbgp,gcp->bsgc', s_re, c_re.astype(f32))
         - jnp.einsum('sbgp,gcp->bsgc', s_im, c_im.astype(f32)))
    y = y.reshape(bsz, seq, D_MODEL) + d_skip.astype(f32) * uf
    act = jax.nn.gelu(y).astype(u.dtype)
    val, gate = jnp.split(act @ w_glu, 2, axis=-1)
    return val * jax.nn.sigmoid(gate)


def _mla_shared_kv(h, kv_w_a, kv_norm, kv_w_b, cos, sin):
    bsz, seq, _ = h.shape
    kv_a = h @ kv_w_a
    c_kv = _rms_norm(kv_a[..., :KV_LORA], kv_norm)
    k_rope = _apply_rope(kv_a[..., KV_LORA:], cos[None], sin[None])
    kv = (c_kv @ kv_w_b).reshape(bsz, seq, MLA_HEADS, QK_NOPE + V_DIM)
    return kv[..., :QK_NOPE], k_rope, kv[..., QK_NOPE:]


def _mla_attention(x, q_w_a, q_norm, q_w_b, o_w, k_nope, k_rope, v, cos, sin):
    bsz, seq, _ = x.shape
    c_q = _rms_norm(x @ q_w_a, q_norm)
    q = (c_q @ q_w_b).reshape(bsz, seq, MLA_HEADS, QK_NOPE + QK_ROPE)
    q_nope = q[..., :QK_NOPE]
    q_rope = _apply_rope(q[..., QK_NOPE:], cos[None, :, None, :], sin[None, :, None, :])
    scale = 1.0 / math.sqrt(QK_NOPE + QK_ROPE)
    outs = []
    for q0 in range(0, seq, Q_BLOCK):
        kv_len = q0 + Q_BLOCK
        s = (jnp.einsum('bqhd,bkhd->bhqk', q_nope[:, q0:kv_len], k_nope[:, :kv_len])
             + jnp.einsum('bqhr,bkr->bhqk', q_rope[:, q0:kv_len], k_rope[:, :kv_len]))
        s = s.astype(jnp.float32) * scale
        q_pos = q0 + jnp.arange(Q_BLOCK)
        k_pos = jnp.arange(kv_len)
        s = jnp.where(k_pos[None, :] <= q_pos[:, None], s, -jnp.inf)
        p = jax.nn.softmax(s, axis=-1).astype(v.dtype)
        outs.append(jnp.einsum('bhqk,bkhd->bqhd', p, v[:, :kv_len]))
    o = jnp.concatenate(outs, axis=1).reshape(bsz, seq, MLA_HEADS * V_DIM)
    return o @ o_w


def _swiglu(x, w_in, w_out):
    g, u = jnp.split(x @ w_in, 2, axis=-1)
    return (jax.nn.silu(g) * u) @ w_out


def _moe_swiglu(x, w_router, w_in, w_out):
    bsz, seq, d = x.shape
    n_tok = bsz * seq
    n_assign = n_tok * TOP_K
    xf = x.reshape(n_tok, d)
    logits = (xf @ w_router).astype(jnp.float32)
    top_val, top_idx = lax.top_k(logits, TOP_K)
    gate = jax.nn.softmax(top_val, axis=-1)
    flat_e = top_idx.reshape(-1)
    flat_tok = jnp.repeat(jnp.arange(n_tok, dtype=jnp.int32), TOP_K)
    flat_w = gate.reshape(-1)
    order = jnp.argsort(flat_e)
    sorted_e = flat_e[order]
    counts = jnp.bincount(flat_e, length=N_EXPERTS)
    starts = jnp.cumsum(counts) - counts
    padded = ((counts + ROUTE_BLOCK - 1) // ROUTE_BLOCK) * ROUTE_BLOCK
    pad_ends = jnp.cumsum(padded)
    pad_starts = pad_ends - padded
    dest = pad_starts[sorted_e] + (jnp.arange(n_assign) - starts[sorted_e])
    n_rows = n_assign + N_EXPERTS * ROUTE_BLOCK
    n_blocks = n_rows // ROUTE_BLOCK
    row_tok = jnp.full((n_rows,), n_tok, jnp.int32).at[dest].set(flat_tok[order])
    row_w = jnp.zeros((n_rows,), jnp.float32).at[dest].set(flat_w[order])
    blk_e = jnp.minimum(jnp.searchsorted(pad_ends, jnp.arange(n_blocks) * ROUTE_BLOCK, side='right'),
                        N_EXPERTS - 1)
    x_pad = jnp.concatenate([xf, jnp.zeros((1, d), xf.dtype)], axis=0)
    xs = x_pad[row_tok].reshape(n_blocks, ROUTE_BLOCK, d)

    def _expert_block(args):
        xb, e = args
        return _swiglu(xb, w_in[e], w_out[e])

    ys = lax.map(_expert_block, (xs, blk_e)).reshape(n_rows, d)
    out = jnp.zeros((n_tok + 1, d), ys.dtype).at[row_tok].add(ys * row_w[:, None].astype(ys.dtype))
    return out[:n_tok].reshape(bsz, seq, d)


def _normal(key, shape, fan_in, scale=1.0):
    return jax.random.normal(key, shape, jnp.float32) * (scale * fan_in ** -0.5)


def setup_inputs(seed: int = 0) -> dict:
    key = jax.random.key(seed)
    k = jax.random.split(key, 28)
    f32 = jnp.float32
    G, P, C = S5_GROUPS, S5_STATE, S5_GROUP
    x = jax.random.normal(k[0], (BATCH, SEQ, D_MODEL), f32)
    s5_lam_re = -0.5 + 0.01 * jax.random.normal(k[1], (N_A_LAYERS, G, P), f32)
    s5_lam_im = (jnp.pi * jnp.arange(P, dtype=f32)[None, None, :]
                 + 0.01 * jax.random.normal(k[2], (N_A_LAYERS, G, P), f32))
    s5_log_step = jax.random.uniform(k[3], (N_A_LAYERS, G), f32,
                                     minval=math.log(S5_DT_MIN), maxval=math.log(S5_DT_MAX))
    s5_b_re = _normal(k[4], (N_A_LAYERS, G, P, C), 2 * C)
    s5_b_im = _normal(k[5], (N_A_LAYERS, G, P, C), 2 * C)
    s5_c_re = _normal(k[6], (N_A_LAYERS, G, C, P), 2 * P)
    s5_c_im = _normal(k[7], (N_A_LAYERS, G, C, P), 2 * P)
    s5_d = jax.random.normal(k[8], (N_A_LAYERS, D_MODEL), f32)
    s5_w_glu = jnp.concatenate([_normal(k[9], (N_A_LAYERS, D_MODEL, D_MODEL), D_MODEL, BETA),
                                _normal(k[10], (N_A_LAYERS, D_MODEL, D_MODEL), D_MODEL)], axis=-1)
    mla_q_w_a = _normal(k[11], (N_B_LAYERS, D_MODEL, Q_LORA), D_MODEL)
    mla_q_norm = 1.0 + 0.01 * jax.random.normal(k[12], (N_B_LAYERS, Q_LORA), f32)
    mla_q_w_b = _normal(k[13], (N_B_LAYERS, Q_LORA, MLA_HEADS * (QK_NOPE + QK_ROPE)), Q_LORA)
    mla_o_w = _normal(k[14], (N_B_LAYERS, MLA_HEADS * V_DIM, D_MODEL), MLA_HEADS * V_DIM, BETA)
    kv_w_a = _normal(k[15], (D_MODEL, KV_LORA + QK_ROPE), D_MODEL)
    kv_norm = 1.0 + 0.01 * jax.random.normal(k[16], (KV_LORA,), f32)
    kv_w_b = jnp.concatenate([_normal(k[17], (KV_LORA, MLA_HEADS, QK_NOPE), KV_LORA),
                              _normal(k[18], (KV_LORA, MLA_HEADS, V_DIM), KV_LORA, BETA)],
                             axis=-1).reshape(KV_LORA, MLA_HEADS * (QK_NOPE + V_DIM))
    ffn_w_in = _normal(k[19], (N_DENSE_FFN, D_MODEL, 2 * FFN_DIM), D_MODEL)
    ffn_w_out = _normal(k[20], (N_DENSE_FFN, FFN_DIM, D_MODEL), FFN_DIM, BETA)
    moe_router = _normal(k[21], (N_MOE_FFN, D_MODEL, N_EXPERTS), D_MODEL)
    moe_w_in = _normal(k[22], (N_MOE_FFN, N_EXPERTS, D_MODEL, 2 * EXPERT_DIM), D_MODEL)
    moe_w_out = _normal(k[23], (N_MOE_FFN, N_EXPERTS, EXPERT_DIM, D_MODEL), EXPERT_DIM, BETA)
    ln_g = 1.0 + 0.01 * jax.random.normal(k[24], (DEPTH, 2, D_MODEL), f32)
    ln_b = 0.01 * jax.random.normal(k[25], (DEPTH, 2, D_MODEL), f32)
    return {'x': x,
            's5_lam_re': s5_lam_re, 's5_lam_im': s5_lam_im, 's5_log_step': s5_log_step,
            's5_b_re': s5_b_re, 's5_b_im': s5_b_im, 's5_c_re': s5_c_re, 's5_c_im': s5_c_im,
            's5_d': s5_d, 's5_w_glu': s5_w_glu,
            'mla_q_w_a': mla_q_w_a, 'mla_q_norm': mla_q_norm, 'mla_q_w_b': mla_q_w_b, 'mla_o_w': mla_o_w,
            'kv_w_a': kv_w_a, 'kv_norm': kv_norm, 'kv_w_b': kv_w_b,
            'ffn_w_in': ffn_w_in, 'ffn_w_out': ffn_w_out,
            'moe_router': moe_router, 'moe_w_in': moe_w_in, 'moe_w_out': moe_w_out,
            'ln_g': ln_g, 'ln_b': ln_b}


def reference(x, s5_lam_re, s5_lam_im, s5_log_step, s5_b_re, s5_b_im, s5_c_re, s5_c_im,
              s5_d, s5_w_glu, mla_q_w_a, mla_q_norm, mla_q_w_b, mla_o_w,
              kv_w_a, kv_norm, kv_w_b, ffn_w_in, ffn_w_out,
              moe_router, moe_w_in, moe_w_out, ln_g, ln_b):
    cos, sin = _rope_tables(x.shape[1])
    k_nope = k_rope = v = None
    for layer in range(DEPTH):
        if layer < N_A_LAYERS:
            i = layer
            mix = _s5_mixer(x, s5_lam_re[i], s5_lam_im[i], s5_log_step[i], s5_b_re[i], s5_b_im[i],
                            s5_c_re[i], s5_c_im[i], s5_d[i], s5_w_glu[i])
        else:
            if layer == N_A_LAYERS:
                k_nope, k_rope, v = _mla_shared_kv(x, kv_w_a, kv_norm, kv_w_b, cos, sin)
            i = layer - N_A_LAYERS
            mix = _mla_attention(x, mla_q_w_a[i], mla_q_norm[i], mla_q_w_b[i], mla_o_w[i],
                                 k_nope, k_rope, v, cos, sin)
        x = _layer_norm(ALPHA * x + mix, ln_g[layer, 0], ln_b[layer, 0])
        if layer % 2 == 0:
            ffn = _swiglu(x, ffn_w_in[layer // 2], ffn_w_out[layer // 2])
        else:
            ffn = _moe_swiglu(x, moe_router[layer // 2], moe_w_in[layer // 2], moe_w_out[layer // 2])
        x = _layer_norm(ALPHA * x + ffn, ln_g[layer, 1], ln_b[layer, 1])
    return x
```

```cpp
#include <hip/hip_runtime.h>
#include <cstdio>
#include <cstdint>

#ifndef MOE_FP8
#define MOE_FP8 1
#endif
#ifndef FFN_DOWN_FP8
#define FFN_DOWN_FP8 1
#endif
#ifndef PG8_ALIGN_EPI
#define PG8_ALIGN_EPI 1
#endif
#ifndef MLA_ABSORB
#define CONV_IN_ATTN 1
#define MLA_ABSORB 1
#endif
#ifndef MK_N_LAUNCHES
#define MK_N_LAUNCHES 1
#endif

#define GAS __attribute__((address_space(1)))
#define LAS __attribute__((address_space(3)))
typedef unsigned short bf16;
typedef short bf16x8 __attribute__((ext_vector_type(8)));
typedef short s16x4 __attribute__((ext_vector_type(4)));
typedef float f32x2 __attribute__((ext_vector_type(2)));
typedef float f32x4 __attribute__((ext_vector_type(4)));
typedef float f32x16 __attribute__((ext_vector_type(16)));
typedef unsigned u32x2 __attribute__((ext_vector_type(2)));
typedef unsigned u32x4 __attribute__((ext_vector_type(4)));
typedef int i32x4 __attribute__((ext_vector_type(4)));
typedef int i32x8 __attribute__((ext_vector_type(8)));
typedef unsigned char fp8;

constexpr int D = 1024, BATCH = 16, SEQ = 2048, NTOK = BATCH * SEQ;
constexpr int S5G = 64, S5C = 16, S5P = 64;
constexpr int LCH = 16, NCHUNK = SEQ / LCH, NBC = BATCH * NCHUNK;
constexpr int A3_LD = 384;
constexpr int HEADS = 8, QKN = 128, QKR = 64, VD = 128, QL = 256, KVL = 128;
constexpr int QKVA_N = 512, QKVB_N = 3584, QKVB_K = 384, QW = HEADS * (QKN + QKR);
constexpr int FFN = 2816, NEXP = 8, EXD = 3584;
constexpr float ALPHA = 1.41421356237f, LN_EPS = 1e-5f, RMS_EPS = 1e-6f;
constexpr float MOE_SC_IN = 32.0f, MOE_SC_OUT = 128.0f;
constexpr int MOE_ROWS = 2 * NTOK + NEXP * 256;

constexpr size_t MiB = 1u << 20;
constexpr size_t WS_CTL = 0, CTL_ZERO_BYTES = 128 * 1024;
constexpr size_t WS_MOEIN = 1 * MiB;
constexpr size_t WS_MOEOUT = WS_MOEIN + 112 * MiB;
constexpr size_t WS_FFNIN = WS_MOEOUT + 56 * MiB;
constexpr size_t WS_FFNOUT = WS_FFNIN + 11 * MiB;
constexpr size_t WS_GLU = WS_FFNOUT + 6 * MiB;
constexpr size_t WS_OW = WS_GLU + 4 * MiB;
constexpr size_t WS_QKVB = WS_OW + 2 * MiB;
constexpr size_t WS_QKVA = WS_QKVB + 3 * MiB;
constexpr size_t WS_S5ST = WS_QKVA + 1 * MiB;
constexpr size_t WS_S5W3 = WS_S5ST + 8 * MiB;
constexpr size_t WS_ROPE = WS_S5W3 + 12 * MiB;
constexpr size_t WS_PTAB = WS_ROPE + 1 * MiB;
constexpr size_t WS_BBTAB = WS_PTAB + 1 * MiB;
constexpr size_t WS_ACTS = WS_BBTAB + 1 * MiB;
constexpr size_t WS_A3 = WS_ACTS;
constexpr size_t WS_SEND = WS_A3 + 96 * MiB;
constexpr size_t WS_ACT = WS_SEND + 64 * MiB;
constexpr size_t WS_H = WS_ACT + 64 * MiB;
constexpr size_t WS_X1 = WS_H + 128 * MiB;
constexpr size_t WS_FFNH = WS_X1 + 64 * MiB;
constexpr size_t WS_X2 = WS_ACTS;
constexpr size_t WS_QKVAF = WS_X2 + 64 * MiB;
constexpr size_t WS_CQKV = WS_QKVAF + 64 * MiB;
constexpr size_t WS_KROPE = WS_CQKV + 24 * MiB;
constexpr size_t WS_QKV = WS_KROPE + 4 * MiB;
constexpr size_t WS_H3 = WS_QKV + 224 * MiB;
constexpr size_t WS_O = WS_H3 + 128 * MiB;
constexpr size_t WS_X3 = WS_ACTS;
constexpr size_t WS_MOEH = WS_X3 + 64 * MiB;
constexpr size_t WS_Y = WS_MOEH + 462 * MiB;
constexpr size_t WS_ROUTE = WS_Y + 132 * MiB;
constexpr size_t WS_END = WS_ROUTE + 2 * MiB;
static_assert(WS_FFNH + 176 * MiB <= WS_END && WS_O + 64 * MiB <= WS_END, "d_ws map");
static_assert(WS_END <= 896 * MiB, "d_ws map exceeds 4x the largest input");
static_assert(WS_H3 >= WS_QKV + (size_t)NTOK * QKVB_N * 2, "d_ws map");

constexpr int CW_BAR = 4096;
constexpr int CW_ECNT = 16384;

constexpr int RING_OFF = 0, RING_BYTES = 131072;
constexpr int IDX_OFF = 131072;
constexpr int LDSCTL_OFF = 139264, MISC_OFF = LDSCTL_OFF + 320;
constexpr int LDS_BYTES = 147456;
constexpr int NWAVES = 8;

#define RLX_AGENT __ATOMIC_RELAXED, __HIP_MEMORY_SCOPE_AGENT
#define LDS_WAIT() asm volatile("s_waitcnt lgkmcnt(0)" ::: "memory")
#define VM_WAIT() asm volatile("s_waitcnt vmcnt(0)" ::: "memory")

__device__ __forceinline__ unsigned cvt_pk_bf16(float lo, float hi) { unsigned r; asm volatile("v_cvt_pk_bf16_f32 %0, %1, %2" : "=v"(r) : "v"(lo), "v"(hi)); return r; }
__device__ __forceinline__ unsigned pk4_fp8(float a, float b, float c, float d) { int r = 0; r = __builtin_amdgcn_cvt_pk_fp8_f32(a, b, r, false); r = __builtin_amdgcn_cvt_pk_fp8_f32(c, d, r, true); return (unsigned)r; }
__device__ __forceinline__ float bf_lo(unsigned w) { return __uint_as_float(w << 16); }
__device__ __forceinline__ float bf_hi(unsigned w) { return __uint_as_float(w & 0xffff0000u); }
template <int CTRL> __device__ __forceinline__ float dpp_mov(float v) { return __builtin_bit_cast(float, __builtin_amdgcn_update_dpp(0, __builtin_bit_cast(int, v), CTRL, 0xf, 0xf, true)); }
__device__ __forceinline__ float wave_sum(float v) {
    v += dpp_mov<0xB1>(v);
    v += dpp_mov<0x4E>(v);
    v += dpp_mov<0x141>(v);
    v += dpp_mov<0x140>(v);
    { auto r = __builtin_amdgcn_permlane16_swap(__float_as_uint(v), __float_as_uint(v), false, false); v = __uint_as_float(r[0]) + __uint_as_float(r[1]); }
    { auto r = __builtin_amdgcn_permlane32_swap(__float_as_uint(v), __float_as_uint(v), false, false); v = __uint_as_float(r[0]) + __uint_as_float(r[1]); }
    return v;
}
__device__ __forceinline__ float sigmoid_f(float x) { return __builtin_amdgcn_rcpf(1.0f + __builtin_amdgcn_exp2f(-1.4426950408889634f * x)); }
__device__ __forceinline__ float gelu_tanh_f(float x) { return x * sigmoid_f(1.5957691216057308f * x * (1.0f + 0.044715f * x * x)); }

namespace pg8 {
constexpr int BM = 256, BK = 64, HALF = 128, HTB = HALF * BK * 2, STAGE_BYTES = 8 * HTB, NXCD = 8, WGM = 8;
__host__ __device__ __forceinline__ int lds_byte(int r, int c) { const int st = (r >> 4) * 2 + (c >> 5), rr = r & 15, cc = c & 31, ob = rr * 64 + cc * 2; return st * 1024 + (ob ^ (((ob >> 9) & 1) << 5)); }
__host__ __device__ __forceinline__ void stage_rc(int b, int& R, int& C) { const int st = b / 1024, sb = b % 1024, swz = sb ^ (((sb >> 9) & 1) << 5); R = (st >> 1) * 16 + swz / 64; C = (st & 1) * 32 + (swz % 64) / 2; }
__host__ __device__ __forceinline__ int perm32(int rho) { const int n = rho >> 4, i = rho & 15; return 8 * (i >> 2) + 4 * n + (i & 3); }

struct Unit { int pm, pn, aux, aux2, nt; const char* a; const char* b; };

__device__ __forceinline__ bool tile_of(long L, int nM, int nN, int& pm, int& pn) {
    const int nwg = nM * nN; if (L >= nwg) return false;
    int wgid = (int)L; { const int q = nwg / NXCD, r = nwg % NXCD, xcd = wgid % NXCD, off = wgid / NXCD; wgid = (xcd < r ? xcd * (q + 1) : r * (q + 1) + (xcd - r) * q) + off; }
    const int nig = WGM * nN, gid = wgid / nig, fm = gid * WGM, gsz = (nM - fm) < WGM ? (nM - fm) : WGM;
    pm = fm + ((wgid % nig) % gsz); pn = (wgid % nig) / gsz; return true;
}

template <class E, class = void> struct epi_after_drain { static constexpr bool value = false; };
template <class E> struct epi_after_drain<E, decltype((void)E::AFTER_DRAIN)> { static constexpr bool value = E::AFTER_DRAIN; };
template <bool F8> struct frag_sel;
template <> struct frag_sel<false> { struct A4 { bf16x8 v[4][2]; }; struct B2 { bf16x8 v[2][2]; }; };
template <> struct frag_sel<true>  { struct A4 { i32x8 v[4]; };     struct B2 { i32x8 v[2]; }; };
template <class Epi, class Sched, bool GATHER, bool FP8 = false>
__device__ __forceinline__ void gemm_phase(LAS unsigned char* lds, const int ldb_, const int lda_, const Sched& S, const Epi& E) {
    int K = ldb_, lda = lda_; asm volatile("" : "+s"(K), "+s"(lda));
    int tid_ = threadIdx.x; asm volatile("" : "+v"(tid_));
    const int tid = tid_, wid = __builtin_amdgcn_readfirstlane(tid >> 6), lane = tid & 63, wr = wid >> 2, wc = wid & 3, fr = lane & 15, fq = lane >> 4;
    int R[2], C[2]; unsigned voffB[2], ca[4];
#pragma unroll
    for (int i = 0; i < 2; ++i) { stage_rc(tid * 16 + i * 8192, R[i], C[i]); const int Rb = Epi::PERM ? ((R[i] & ~31) + perm32(R[i] & 31)) : R[i];
        voffB[i] = (unsigned)(Rb * K + C[i] * 2); ca[i] = (unsigned)(R[i] * lda + C[i] * 2); ca[2 + i] = (unsigned)((HALF + R[i]) * lda + C[i] * 2); }
    const size_t kstep = (size_t)(BK * 2);
    const size_t hstepB = (size_t)HALF * K;
    const unsigned ldsw = (unsigned)wid * 1024u;
    const int aoff = lds_byte(wr * 64 + fr, fq * 8), boff = lds_byte(wc * 32 + fr, fq * 8);
#define PG8_SA(b, h) (((b) * 2 + (h)) * HTB)
#define PG8_SB(b, h) ((4 + (b) * 2 + (h)) * HTB)
#define PG8_STAGE(bufoff, gbase, o0, o1) do { \
        __builtin_amdgcn_global_load_lds((const unsigned*)((const char*)(gbase) + (o0)), (LAS unsigned*)(lds + (bufoff) + ldsw), 16, 0, 0); \
        __builtin_amdgcn_global_load_lds((const unsigned*)((const char*)(gbase) + (o1)), (LAS unsigned*)(lds + (bufoff) + ldsw + 8192), 16, 0, 0); } while (0)
#define PG8_STAGEB(bufoff, gbase) PG8_STAGE(bufoff, gbase, voffB[0], voffB[1])
#define PG8_LD16(off) (*(const LAS i32x4*)(lds + (off)))
#define PG8_LDA(dst, b, h) do { _Pragma("unroll") for (int m = 0; m < 4; ++m) { \
        if constexpr (FP8) { const i32x4 lo_ = PG8_LD16(PG8_SA(b, h) + aoff + m * 2048), hi_ = PG8_LD16(PG8_SA(b, h) + aoff + m * 2048 + 1024); dst.v[m] = __builtin_shufflevector(lo_, hi_, 0, 1, 2, 3, 4, 5, 6, 7); } \
        else { _Pragma("unroll") for (int k = 0; k < 2; ++k) dst.v[m][k] = *(const LAS bf16x8*)(lds + PG8_SA(b, h) + aoff + m * 2048 + k * 1024); } } } while (0)
#define PG8_LDB(dst, b, h) do { _Pragma("unroll") for (int n = 0; n < 2; ++n) { \
        if constexpr (FP8) { const i32x4 lo_ = PG8_LD16(PG8_SB(b, h) + boff + n * 2048), hi_ = PG8_LD16(PG8_SB(b, h) + boff + n * 2048 + 1024); dst.v[n] = __builtin_shufflevector(lo_, hi_, 0, 1, 2, 3, 4, 5, 6, 7); } \
        else { _Pragma("unroll") for (int k = 0; k < 2; ++k) dst.v[n][k] = *(const LAS bf16x8*)(lds + PG8_SB(b, h) + boff + n * 2048 + k * 1024); } } } while (0)
#define PG8_MMA(ai, bj, At, Bt) do { __builtin_amdgcn_s_setprio(1); \
        if constexpr (FP8) { _Pragma("unroll") for (int m = 0; m < 4; ++m) _Pragma("unroll") for (int n = 0; n < 2; ++n) \
            asm volatile("v_mfma_f32_16x16x128_f8f6f4 %0, %1, %2, %0" : "+v"(acc[ai][bj][m][n]) : "v"(Bt.v[n]), "v"(At.v[m])); } \
        else { _Pragma("unroll") for (int m = 0; m < 4; ++m) _Pragma("unroll") for (int n = 0; n < 2; ++n) _Pragma("unroll") for (int k = 0; k < 2; ++k) \
            acc[ai][bj][m][n] = __builtin_amdgcn_mfma_f32_16x16x32_bf16(Bt.v[n][k], At.v[m][k], acc[ai][bj][m][n], 0, 0, 0); } \
        __builtin_amdgcn_s_setprio(0); } while (0)
#define PG8_WAIT_V(n) asm volatile("s_waitcnt vmcnt(" #n ")" ::: "memory")
#define PG8_WAIT_L(n) asm volatile("s_waitcnt lgkmcnt(" #n ")" ::: "memory")
#define PG8_BAR __builtin_amdgcn_s_barrier()
#define PG8_SCHED __builtin_amdgcn_sched_barrier(0)
    Unit cur, nxt; int ui = 0;
    if (!S.next(0, cur)) return;
    if constexpr (GATHER) S.gather(cur, R, C, ca);
    f32x4 acc[2][2][4][2];
#pragma unroll
    for (int a = 0; a < 2; ++a)
#pragma unroll
        for (int b = 0; b < 2; ++b)
#pragma unroll
            for (int m = 0; m < 4; ++m)
#pragma unroll
                for (int n = 0; n < 2; ++n) acc[a][b][m][n] = (f32x4){0.f, 0.f, 0.f, 0.f};
    typedef typename frag_sel<FP8>::A4 FragA; typedef typename frag_sel<FP8>::B2 FragB;
    FragA At; FragB B0, B1;
    const char* cA = cur.a; const char* cB = cur.b;
    PG8_STAGEB(PG8_SB(0, 0), cB); PG8_STAGEB(PG8_SB(0, 1), cB + hstepB); PG8_STAGE(PG8_SA(0, 0), cA, ca[0], ca[1]); PG8_STAGE(PG8_SA(0, 1), cA, ca[2], ca[3]);
    if (wr == 1) PG8_BAR;
    PG8_WAIT_V(2); PG8_BAR;
    PG8_STAGEB(PG8_SB(1, 0), cB + kstep); PG8_STAGE(PG8_SA(1, 0), cA + kstep, ca[0], ca[1]); PG8_STAGEB(PG8_SB(1, 1), cB + hstepB + kstep);
    PG8_WAIT_V(6); PG8_BAR;
    for (;;) {
        const bool has_next = S.next(ui + 1, nxt);
        const char* nA = has_next ? nxt.a : cA; const char* nB = has_next ? nxt.b : cB;
        const int nt = cur.nt;
        for (int t = 0; t < nt; t += 2) {
            const bool last = (t == nt - 2);
            const char* a1 = cA + (size_t)(t + 1) * kstep;
            const char* a2 = last ? nA : cA + (size_t)(t + 2) * kstep; const char* b2 = last ? nB : cB + (size_t)(t + 2) * kstep;
            const char* a3 = a2 + kstep; const char* b3 = b2 + kstep;
            PG8_LDB(B0, 0, 0); PG8_LDB(B1, 0, 1); PG8_SCHED; PG8_LDA(At, 0, 0); PG8_STAGE(PG8_SA(1, 1), a1, ca[2], ca[3]);
            PG8_WAIT_V(8); PG8_WAIT_L(0); PG8_BAR; PG8_MMA(0, 0, At, B0); PG8_MMA(0, 1, At, B1); PG8_BAR; PG8_SCHED;
            if constexpr (GATHER) { if (last && has_next) {
                int t2 = tid; asm volatile("" : "+v"(t2)); int R2[2], C2[2]; stage_rc(t2 * 16, R2[0], C2[0]); stage_rc(t2 * 16 + 8192, R2[1], C2[1]);
#pragma unroll
                for (int k = 0; k < 4; ++k) ca[k] = S.off_of(*(const LAS int*)(lds + IDX_OFF + wid * 1024 + k * 256 + lane * 4), C2[k & 1]); } }
            PG8_LDA(At, 0, 1);
            if constexpr (GATHER) { if (t == 0 && has_next) {
                int t2 = tid; asm volatile("" : "+v"(t2)); int R2[2], C2[2]; stage_rc(t2 * 16, R2[0], C2[0]); stage_rc(t2 * 16 + 8192, R2[1], C2[1]);
#pragma unroll
                for (int k = 0; k < 4; ++k) __builtin_amdgcn_global_load_lds((const unsigned*)S.idx_src(nxt, (k >> 1) * HALF + R2[k & 1]), (LAS unsigned*)(lds + IDX_OFF + wid * 1024 + k * 256), 4, 0, 0); } }
            PG8_STAGEB(PG8_SB(0, 0), b2); PG8_STAGEB(PG8_SB(0, 1), b2 + hstepB); PG8_STAGE(PG8_SA(0, 0), a2, ca[0], ca[1]);
            PG8_WAIT_V(8); PG8_WAIT_L(0); PG8_BAR; PG8_MMA(1, 0, At, B0); PG8_MMA(1, 1, At, B1); PG8_BAR; PG8_SCHED;
            PG8_LDB(B0, 1, 0); PG8_LDB(B1, 1, 1); PG8_SCHED; PG8_LDA(At, 1, 0); PG8_STAGE(PG8_SA(0, 1), a2, ca[2], ca[3]);
            PG8_WAIT_V(8); PG8_WAIT_L(0); PG8_BAR; PG8_MMA(0, 0, At, B0); PG8_MMA(0, 1, At, B1); PG8_BAR; PG8_SCHED;
            PG8_LDA(At, 1, 1); PG8_STAGEB(PG8_SB(1, 0), b3); PG8_STAGEB(PG8_SB(1, 1), b3 + hstepB); PG8_STAGE(PG8_SA(1, 0), a3, ca[0], ca[1]);
            PG8_WAIT_V(8); PG8_WAIT_L(0); PG8_BAR; PG8_MMA(1, 0, At, B0); PG8_MMA(1, 1, At, B1); PG8_BAR; PG8_SCHED;
        }
        if (PG8_ALIGN_EPI) { if (wr == 0) PG8_BAR; }
        if constexpr (FP8) asm volatile("s_nop 15\n\ts_nop 15" ::: "memory");
        if constexpr (!epi_after_drain<Epi>::value) E(acc, cur, wr, wc, fr, fq);
        if (!has_next) break;
#pragma unroll
        for (int a = 0; a < 2; ++a)
#pragma unroll
            for (int b = 0; b < 2; ++b)
#pragma unroll
                for (int m = 0; m < 4; ++m)
#pragma unroll
                    for (int n = 0; n < 2; ++n) acc[a][b][m][n] = (f32x4){0.f, 0.f, 0.f, 0.f};
        cur = nxt; cA = nA; cB = nB; ++ui;
        if (PG8_ALIGN_EPI) { if (wr == 1) PG8_BAR; }
    }
    PG8_WAIT_V(0);
    if (!PG8_ALIGN_EPI) { if (wr == 0) PG8_BAR; }
    PG8_BAR;
    if constexpr (epi_after_drain<Epi>::value) E.after(acc, cur, wr, wc, fr, fq, lds, lane);
#undef PG8_SA
#undef PG8_SB
#undef PG8_STAGE
#undef PG8_STAGEB
#undef PG8_LDA
#undef PG8_LD16
#undef PG8_LDB
#undef PG8_MMA
#undef PG8_WAIT_V
#undef PG8_WAIT_L
#undef PG8_BAR
#undef PG8_SCHED
}

struct DenseSched {
    const char* A; const char* Bt; int nM, nN, G, c; size_t astep, bstep; int nt;
    __device__ __forceinline__ bool next(int i, Unit& u) const { if (!tile_of((long)i * G + c, nM, nN, u.pm, u.pn)) return false; u.aux = 0; u.aux2 = -1; u.nt = nt; u.a = A + (size_t)u.pm * astep; u.b = Bt + (size_t)u.pn * bstep; return true; }
};
struct QkvbSched {
    const char* A; const char* Bt; int G, c;
    __device__ __forceinline__ bool next(int i, Unit& u) const { if (!tile_of((long)i * G + c, NTOK / 256, QKVB_N / 256, u.pm, u.pn)) return false; u.aux = 0; u.aux2 = -1;
        const bool kv = u.pn >= QW / 256; u.nt = kv ? 2 : 4; const size_t ko = kv ? (size_t)QL * 2 : 0;
        u.a = A + (size_t)u.pm * 256 * QKVB_K * 2 + ko; u.b = Bt + (size_t)u.pn * 256 * QKVB_K * 2 + ko; return true; }
};
struct GroupSched {
    const char* A; const char* Bt; int G, c; size_t agrp, bgrp, astep; int nt;
    __device__ __forceinline__ bool next(int i, Unit& u) const {
        const long L = (long)i * G + c; if (L >= 512) return false;
        const int xcd = (int)(L % 8), off = (int)(L / 8), w = xcd * 64 + off;
        u.aux = w >> 3; u.aux2 = -1; u.pm = w & 7; u.pn = 0; u.nt = nt; u.a = A + (size_t)u.aux * agrp + (size_t)u.pm * astep; u.b = Bt + (size_t)u.aux * bgrp; return true; }
};
struct MoeSched {
    const char* A; const char* Bt; const int* row_tok; int nN, G, c, nt; size_t astep, bexp, bstep; int rowb;
    int cnt[NEXP], ts[NEXP + 1];
    __device__ __forceinline__ void init(const unsigned* ecnt) {
        int t = 0;
#pragma unroll
        for (int e = 0; e < NEXP; ++e) { cnt[e] = (int)__builtin_amdgcn_readfirstlane(__hip_atomic_load(ecnt + 64 * e, __ATOMIC_RELAXED, __HIP_MEMORY_SCOPE_AGENT)); ts[e] = t; t += (cnt[e] + 255) >> 8; }
        ts[NEXP] = t;
    }
    __device__ __forceinline__ int expert_of(int T) const { int e = 0;
#pragma unroll
        for (int k = 1; k < NEXP; ++k) e += (T >= ts[k]) ? 1 : 0;
        return e; }
    __device__ __forceinline__ bool next(int i, Unit& u) const {
        if (!tile_of((long)i * G + c, ts[NEXP], nN, u.pm, u.pn)) return false;
        const int e = expert_of(u.pm); u.aux = e; u.aux2 = -1; u.nt = nt; u.a = A + (size_t)u.pm * astep; u.b = Bt + (size_t)e * bexp + (size_t)u.pn * bstep; return true; }
    __device__ __forceinline__ const int* idx_src(const Unit& u, int row) const {
        int tse = 0, ce = 0;
#pragma unroll
        for (int k = 0; k < NEXP; ++k) { tse = (u.aux == k) ? ts[k] : tse; ce = (u.aux == k) ? cnt[k] : ce; }
        int r = (u.pm - tse) * 256 + row; r = (r < ce) ? r : 0;
        return row_tok + u.aux * NTOK + r; }
    __device__ __forceinline__ unsigned off_of(int tok, int Ci) const { return (unsigned)tok * (unsigned)rowb + (unsigned)Ci * 2u; }
    __device__ __forceinline__ void gather(const Unit& u, const int (&R)[2], const int (&C)[2], unsigned (&off)[4]) const {
        int tok[4];
#pragma unroll
        for (int h = 0; h < 2; ++h)
#pragma unroll
            for (int i = 0; i < 2; ++i) tok[h * 2 + i] = *idx_src(u, h * HALF + R[i]);
#pragma unroll
        for (int h = 0; h < 2; ++h)
#pragma unroll
            for (int i = 0; i < 2; ++i) off[h * 2 + i] = off_of(tok[h * 2 + i], C[i]);
    }
};

constexpr int MOE_KS = 7;
struct MoeDownSched : MoeSched {
    int T0, ntail;
    __device__ __forceinline__ void init2() { const int T = ts[NEXP], per = (G % nN == 0) ? G / nN : 1; T0 = (T / per) * per; ntail = (T - T0) * nN * MOE_KS; }
    __device__ __forceinline__ bool next(int i, Unit& u) const {
        const long L = (long)i * G + c; const int nnorm = T0 * nN;
        if (L < nnorm) { tile_of(L, T0, nN, u.pm, u.pn); u.aux2 = -1; u.nt = nt; const int e = expert_of(u.pm); u.aux = e; u.a = A + (size_t)u.pm * astep; u.b = Bt + (size_t)e * bexp + (size_t)u.pn * bstep; return true; }
        const long L2 = L - nnorm; if (L2 >= ntail) return false;
        const int ks = (int)(L2 % MOE_KS), r = (int)(L2 / MOE_KS); u.pn = r % nN; u.pm = T0 + r / nN; u.aux2 = ks; u.nt = nt / MOE_KS;
        const int e = expert_of(u.pm); u.aux = e; const size_t ko = (size_t)ks * (nt / MOE_KS) * 128;
        u.a = A + (size_t)u.pm * astep + ko; u.b = Bt + (size_t)e * bexp + (size_t)u.pn * bstep + ko; return true; }
};
struct EpiMoeDown {
    static constexpr bool PERM = true;
    bf16* O; float* slab; int T0, tail_rows; float s;
    __device__ __forceinline__ void operator()(const f32x4 (&acc)[2][2][4][2], const Unit& u, int wr, int wc, int fr, int fq) const {
        const int col0 = u.pn * BM + wc * 32 + 8 * fq;
        if (u.aux2 < 0) { const int row0 = u.pm * BM + wr * 64 + fr;
#pragma unroll
            for (int ai = 0; ai < 2; ++ai)
#pragma unroll
                for (int m = 0; m < 4; ++m) { bf16* rowp = O + (size_t)(row0 + ai * HALF + m * 16) * D + col0;
#pragma unroll
                    for (int bj = 0; bj < 2; ++bj) { const f32x4 v0 = acc[ai][bj][m][0] * s, v1 = acc[ai][bj][m][1] * s;
                        u32x4 w; w.x = cvt_pk_bf16(v0[0], v0[1]); w.y = cvt_pk_bf16(v0[2], v0[3]); w.z = cvt_pk_bf16(v1[0], v1[1]); w.w = cvt_pk_bf16(v1[2], v1[3]);
                        *(u32x4*)(rowp + bj * HALF) = w; } }
        } else { const int row0 = u.aux2 * tail_rows + (u.pm - T0) * BM + wr * 64 + fr;
#pragma unroll
            for (int ai = 0; ai < 2; ++ai)
#pragma unroll
                for (int m = 0; m < 4; ++m) { float* rowp = slab + (size_t)(row0 + ai * HALF + m * 16) * D + col0;
#pragma unroll
                    for (int bj = 0; bj < 2; ++bj) { *(f32x4*)(rowp + bj * HALF) = acc[ai][bj][m][0] * s; *(f32x4*)(rowp + bj * HALF + 4) = acc[ai][bj][m][1] * s; } }
        }
    }
};

struct EpiF32 {
    static constexpr bool PERM = false;
    float* Cp; int ldc;
    __device__ __forceinline__ void operator()(const f32x4 (&acc)[2][2][4][2], const Unit& u, int wr, int wc, int fr, int fq) const {
        const int row0 = u.pm * BM + wr * 64 + fr, col0 = u.pn * BM + wc * 32 + 4 * fq;
#pragma unroll
        for (int ai = 0; ai < 2; ++ai)
#pragma unroll
            for (int m = 0; m < 4; ++m) { float* rowp = Cp + (size_t)(row0 + ai * HALF + m * 16) * ldc + col0;
#pragma unroll
                for (int bj = 0; bj < 2; ++bj)
#pragma unroll
                    for (int n = 0; n < 2; ++n) *(f32x4*)(rowp + bj * HALF + n * 16) = acc[ai][bj][m][n]; }
    }
};
struct EpiS1 {
    static constexpr bool PERM = false;
    float* Send;
    __device__ __forceinline__ void operator()(const f32x4 (&acc)[2][2][4][2], const Unit& u, int wr, int wc, int fr, int fq) const {
        float* base = Send + ((size_t)u.aux * NBC + u.pm * BM + wr * 64 + fr) * 128 + wc * 32 + 4 * fq;
#pragma unroll
        for (int ai = 0; ai < 2; ++ai)
#pragma unroll
            for (int m = 0; m < 4; ++m)
#pragma unroll
                for (int n = 0; n < 2; ++n) *(f32x4*)(base + (size_t)(ai * HALF + m * 16) * 128 + n * 16) = acc[ai][0][m][n];
    }
};
struct EpiS3 {
    static constexpr bool PERM = true;
    bf16* act;
    __device__ __forceinline__ void operator()(const f32x4 (&acc)[2][2][4][2], const Unit& u, int wr, int wc, int fr, int fq) const {
        const int g = u.aux;
#pragma unroll
        for (int ai = 0; ai < 2; ++ai)
#pragma unroll
            for (int m = 0; m < 4; ++m) { const int bc = u.pm * BM + ai * HALF + wr * 64 + m * 16 + fr, b = bc >> 7, c = bc & 127;
#pragma unroll
                for (int bj = 0; bj < 2; ++bj) { const int tl = 8 * bj + 2 * wc + (fq >> 1);
                    const f32x4 v0 = acc[ai][bj][m][0], v1 = acc[ai][bj][m][1];
                    u32x4 w; w.x = cvt_pk_bf16(gelu_tanh_f(v0[0]), gelu_tanh_f(v0[1])); w.y = cvt_pk_bf16(gelu_tanh_f(v0[2]), gelu_tanh_f(v0[3]));
                    w.z = cvt_pk_bf16(gelu_tanh_f(v1[0]), gelu_tanh_f(v1[1])); w.w = cvt_pk_bf16(gelu_tanh_f(v1[2]), gelu_tanh_f(v1[3]));
                    *(u32x4*)(act + (size_t)(b * SEQ + c * LCH + tl) * D + g * 16 + (fq & 1) * 8) = w; } }
    }
};
struct EpiGLU {
    static constexpr bool PERM = true;
    bf16* out;
    __device__ __forceinline__ void operator()(const f32x4 (&acc)[2][2][4][2], const Unit& u, int wr, int wc, int fr, int fq) const {
        const int row0 = u.pm * BM + wr * 64 + fr, col0 = u.pn * HALF + wc * 32 + 8 * fq;
#pragma unroll
        for (int ai = 0; ai < 2; ++ai)
#pragma unroll
            for (int m = 0; m < 4; ++m) { float h[8];
#pragma unroll
                for (int n = 0; n < 2; ++n)
#pragma unroll
                    for (int j = 0; j < 4; ++j) h[n * 4 + j] = acc[ai][0][m][n][j] * sigmoid_f(acc[ai][1][m][n][j]);
                u32x4 w; w.x = cvt_pk_bf16(h[0], h[1]); w.y = cvt_pk_bf16(h[2], h[3]); w.z = cvt_pk_bf16(h[4], h[5]); w.w = cvt_pk_bf16(h[6], h[7]);
                *(u32x4*)(out + (size_t)(row0 + ai * HALF + m * 16) * D + col0) = w; }
    }
};
struct EpiSwiGLU {
    static constexpr bool PERM = true;
    bf16* Hb; int ldh;
    __device__ __forceinline__ void operator()(const f32x4 (&acc)[2][2][4][2], const Unit& u, int wr, int wc, int fr, int fq) const {
        const int row0 = u.pm * BM + wr * 64 + fr, col0 = u.pn * HALF + wc * 32 + 8 * fq;
#pragma unroll
        for (int ai = 0; ai < 2; ++ai)
#pragma unroll
            for (int m = 0; m < 4; ++m) { float h[8];
#pragma unroll
                for (int n = 0; n < 2; ++n)
#pragma unroll
                    for (int j = 0; j < 4; ++j) { const float g = acc[ai][0][m][n][j], uu = acc[ai][1][m][n][j]; h[n * 4 + j] = g * sigmoid_f(g) * uu; }
                u32x4 w; w.x = cvt_pk_bf16(h[0], h[1]); w.y = cvt_pk_bf16(h[2], h[3]); w.z = cvt_pk_bf16(h[4], h[5]); w.w = cvt_pk_bf16(h[6], h[7]);
                *(u32x4*)(Hb + (size_t)(row0 + ai * HALF + m * 16) * ldh + col0) = w; }
    }
};
struct EpiSwiGLU8 {
    static constexpr bool PERM = true;
    fp8* Hq; int ldh; float s;
    __device__ __forceinline__ void operator()(const f32x4 (&acc)[2][2][4][2], const Unit& u, int wr, int wc, int fr, int fq) const {
        const int row0 = u.pm * BM + wr * 64 + fr, col0 = u.pn * HALF + wc * 32 + 8 * fq;
#pragma unroll
        for (int ai = 0; ai < 2; ++ai)
#pragma unroll
            for (int m = 0; m < 4; ++m) { float h[8];
#pragma unroll
                for (int n = 0; n < 2; ++n)
#pragma unroll
                    for (int j = 0; j < 4; ++j) { const float g = acc[ai][0][m][n][j] * s, uu = acc[ai][1][m][n][j] * s; h[n * 4 + j] = g * sigmoid_f(g) * uu; }
                u32x2 w; w.x = pk4_fp8(h[0], h[1], h[2], h[3]); w.y = pk4_fp8(h[4], h[5], h[6], h[7]);
                *(u32x2*)(Hq + (size_t)(row0 + ai * HALF + m * 16) * ldh + col0) = w; }
    }
};
struct EpiBf16S {
    static constexpr bool PERM = true;
    bf16* O; int ldc; float s;
    __device__ __forceinline__ void operator()(const f32x4 (&acc)[2][2][4][2], const Unit& u, int wr, int wc, int fr, int fq) const {
        const int row0 = u.pm * BM + wr * 64 + fr, col0 = u.pn * BM + wc * 32 + 8 * fq;
#pragma unroll
        for (int ai = 0; ai < 2; ++ai)
#pragma unroll
            for (int m = 0; m < 4; ++m) { bf16* rowp = O + (size_t)(row0 + ai * HALF + m * 16) * ldc + col0;
#pragma unroll
                for (int bj = 0; bj < 2; ++bj) { const f32x4 v0 = acc[ai][bj][m][0] * s, v1 = acc[ai][bj][m][1] * s;
                    u32x4 w; w.x = cvt_pk_bf16(v0[0], v0[1]); w.y = cvt_pk_bf16(v0[2], v0[3]); w.z = cvt_pk_bf16(v1[0], v1[1]); w.w = cvt_pk_bf16(v1[2], v1[3]);
                    *(u32x4*)(rowp + bj * HALF) = w; } }
    }
};
struct EpiQkvaPrep {
    static constexpr bool PERM = false, AFTER_DRAIN = true;
    bf16* cqkv; bf16* krope; const float* qnorm; const float* kvnorm; const float* cosT; const float* sinT;
    __device__ __forceinline__ void operator()(const f32x4 (&)[2][2][4][2], const Unit&, int, int, int, int) const {}
    __device__ __forceinline__ void after(const f32x4 (&acc)[2][2][4][2], const Unit& u, int wr, int wc, int fr, int fq, LAS unsigned char* lds, int lane) const {
        LAS float* P = (LAS float*)lds;
        LAS float* RT = (LAS float*)(lds + 4096);
        const bool t1 = u.pn == 1; (void)lane;
#pragma unroll
        for (int ai = 0; ai < 2; ++ai)
#pragma unroll
            for (int m = 0; m < 4; ++m) { const int row = ai * HALF + wr * 64 + m * 16 + fr; float s = 0.f;
#pragma unroll
                for (int n = 0; n < 2; ++n) { const f32x4 a = acc[ai][0][m][n], b = acc[ai][1][m][n]; s += (a[0] * a[0] + a[1] * a[1]) + (a[2] * a[2] + a[3] * a[3]);
                    if (!t1) s += (b[0] * b[0] + b[1] * b[1]) + (b[2] * b[2] + b[3] * b[3]);
                    else if (wc < 2) *(LAS f32x4*)(RT + row * 64 + 32 * wc + 16 * n + 4 * fq) = b; }
                s += __shfl_xor(s, 16); s += __shfl_xor(s, 32);
                if (fq == 0) P[row * 4 + wc] = s; }
        asm volatile("s_waitcnt lgkmcnt(0)" ::: "memory"); __builtin_amdgcn_s_barrier(); asm volatile("" ::: "memory");
        const float* gn = t1 ? kvnorm : qnorm; const float inv_n = t1 ? (1.f / KVL) : (1.f / QL);
        f32x4 g[2][2];
#pragma unroll
        for (int bj = 0; bj < 2; ++bj)
#pragma unroll
            for (int n = 0; n < 2; ++n) g[bj][n] = (t1 && bj == 1) ? (f32x4){0.f, 0.f, 0.f, 0.f} : *(const f32x4*)(gn + bj * HALF + wc * 32 + n * 16 + 4 * fq);
#pragma unroll
        for (int ai = 0; ai < 2; ++ai)
#pragma unroll
            for (int m = 0; m < 4; ++m) { const int row = ai * HALF + wr * 64 + m * 16 + fr; const size_t grow = (size_t)u.pm * BM + row;
                const f32x4 pp = *(const LAS f32x4*)(P + row * 4); const float rstd = 1.f / sqrtf(((pp[0] + pp[1]) + (pp[2] + pp[3])) * inv_n + RMS_EPS);
                bf16* crow = cqkv + grow * QKVB_K + (t1 ? QL : 0) + wc * 32 + 4 * fq;
#pragma unroll
                for (int n = 0; n < 2; ++n) { const f32x4 a = acc[ai][0][m][n] * rstd * g[0][n]; u32x2 w; w.x = cvt_pk_bf16(a[0], a[1]); w.y = cvt_pk_bf16(a[2], a[3]); *(u32x2*)(crow + n * 16) = w;
                    if (!t1) { const f32x4 b = acc[ai][1][m][n] * rstd * g[1][n]; u32x2 w2; w2.x = cvt_pk_bf16(b[0], b[1]); w2.y = cvt_pk_bf16(b[2], b[3]); *(u32x2*)(crow + HALF + n * 16) = w2; }
                    else if (wc < 2) { const int i0 = 16 * n + 4 * fq, pos = (int)(grow & (SEQ - 1)); const f32x4 cs = *(const f32x4*)(cosT + pos * 32 + i0), sn = *(const f32x4*)(sinT + pos * 32 + i0);
                        const f32x4 mine = acc[ai][1][m][n], other = *(const LAS f32x4*)(RT + row * 64 + 32 * (1 - wc) + i0);
                        const f32x4 o = (wc == 0) ? (mine * cs - other * sn) : (other * sn + mine * cs);
                        u32x2 w3; w3.x = cvt_pk_bf16(o[0], o[1]); w3.y = cvt_pk_bf16(o[2], o[3]); *(u32x2*)(krope + grow * 64 + 32 * wc + i0) = w3; } } }
    }
};
struct EpiBf16 {
    static constexpr bool PERM = true;
    bf16* O; int ldc;
    __device__ __forceinline__ void operator()(const f32x4 (&acc)[2][2][4][2], const Unit& u, int wr, int wc, int fr, int fq) const {
        const int row0 = u.pm * BM + wr * 64 + fr, col0 = u.pn * BM + wc * 32 + 8 * fq;
#pragma unroll
        for (int ai = 0; ai < 2; ++ai)
#pragma unroll
            for (int m = 0; m < 4; ++m) { bf16* rowp = O + (size_t)(row0 + ai * HALF + m * 16) * ldc + col0;
#pragma unroll
                for (int bj = 0; bj < 2; ++bj) { const f32x4 v0 = acc[ai][bj][m][0], v1 = acc[ai][bj][m][1];
                    u32x4 w; w.x = cvt_pk_bf16(v0[0], v0[1]); w.y = cvt_pk_bf16(v0[2], v0[3]); w.z = cvt_pk_bf16(v1[0], v1[1]); w.w = cvt_pk_bf16(v1[2], v1[3]);
                    *(u32x4*)(rowp + bj * HALF) = w; } }
    }
};
}

namespace att {
constexpr int KVBLK = 64, QBLK = 32, QB = 256;
constexpr int SHM_V = KVBLK * 128 * 2, SHM_K = KVBLK * 128 * 2, SHM_R = KVBLK * 64 * 2;
constexpr int OFF_V = 0, OFF_K = 2 * SHM_V, OFF_R = OFF_K + 2 * SHM_K, OFF_WS = OFF_R + 2 * SHM_R, ATT_LDS = OFF_WS + 8 * 64 * 4;
constexpr float SCALE = 0.07216878364870322f;
constexpr float THR = 8.f;
#define KSWZ(row, colB) ((row) * 256 + ((colB) ^ (((row) & 7) << 4)))
#define RSWZ(row, colB) ((row) * 128 + ((colB) ^ (((row) & 7) << 4)))
#define SBAR() __builtin_amdgcn_sched_barrier(0)
__device__ __forceinline__ int v_st(int k, int c) { const int kk = (k & ~0xC) | ((k & 4) << 1) | ((k & 8) >> 1); return ((kk >> 3) * 4 + (c >> 5)) * 512 + ((kk & 7) * 32 + (c & 31)) * 2; }
__device__ __forceinline__ int v_rd_base(int lane) { return ((lane & 3) << 3) | (((lane >> 2) & 3) << 6) | (((lane >> 4) & 1) << 5) | (((lane >> 5) & 1) << 8); }
constexpr int v_rd_off(int d0, int ks, int half) { return d0 * 512 + ks * 4096 + half * 2048; }
__device__ __forceinline__ int crow(int r, int hi) { return (r & 3) + 8 * (r >> 2) + 4 * hi; }
__device__ __forceinline__ void mask_tile(f32x16& p0, f32x16& p1, int dq) {
    const float NEG = -__builtin_inff();
#pragma unroll
    for (int r = 0; r < 16; ++r) {
        const int c = (r & 3) + 8 * (r >> 2);
        if (dq - c < 0) p0[r] = NEG;
        if (dq - c - 32 < 0) p1[r] = NEG;
    }
}
__device__ __forceinline__ void partialSM(f32x16& p0, f32x16& p1, float& m_reg, float& mn, float& alpha) {
    float pmax = p0[0];
#pragma unroll
    for (int r = 1; r < 16; ++r) pmax = fmaxf(pmax, p0[r]);
#pragma unroll
    for (int r = 0; r < 16; ++r) pmax = fmaxf(pmax, p1[r]);
    { auto rr = __builtin_amdgcn_permlane32_swap(__float_as_uint(pmax), __float_as_uint(pmax), false, false);
      pmax = fmaxf(__uint_as_float(rr[0]), __uint_as_float(rr[1])); }
    constexpr float C2 = 1.4426950408889634f * SCALE;
    if (__builtin_expect(__all((pmax - m_reg) * SCALE <= THR), 1)) { mn = m_reg; alpha = 1.f; }
    else { mn = fmaxf(m_reg, pmax); alpha = __builtin_amdgcn_exp2f((m_reg - mn) * C2); m_reg = mn; }
    const float mnL = -mn * C2;
#pragma unroll
    for (int r = 0; r < 16; ++r) p0[r] = __builtin_amdgcn_exp2f(fmaf(p0[r], C2, mnL));
#pragma unroll
    for (int r = 0; r < 16; ++r) p1[r] = __builtin_amdgcn_exp2f(fmaf(p1[r], C2, mnL));
}
__device__ __forceinline__ void finishSM(f32x16& p0, f32x16& p1, float alpha, float& l_reg, bf16x8& pa0, bf16x8& pa1, bf16x8& pa2, bf16x8& pa3) {
    float ps = 0;
#pragma unroll
    for (int r = 0; r < 16; ++r) ps += p0[r];
#pragma unroll
    for (int r = 0; r < 16; ++r) ps += p1[r];
    { auto rr = __builtin_amdgcn_permlane32_swap(__float_as_uint(ps), __float_as_uint(ps), false, false);
      ps = __uint_as_float(rr[0]) + __uint_as_float(rr[1]); }
    l_reg = l_reg * alpha + ps;
#define PK4(P, B_, OUT) do { unsigned a0 = cvt_pk_bf16(P[B_+0], P[B_+1]), a1 = cvt_pk_bf16(P[B_+2], P[B_+3]);                          \
        unsigned b0 = cvt_pk_bf16(P[B_+4], P[B_+5]), b1 = cvt_pk_bf16(P[B_+6], P[B_+7]);                                             \
        auto r0 = __builtin_amdgcn_permlane32_swap(a0, b0, false, false); auto r1 = __builtin_amdgcn_permlane32_swap(a1, b1, false, false); \
        u32x4 w = {r0[0], r1[0], r0[1], r1[1]}; OUT = *reinterpret_cast<bf16x8*>(&w); } while (0)
    PK4(p0, 0, pa0); PK4(p0, 8, pa1); PK4(p1, 0, pa2); PK4(p1, 8, pa3);
#undef PK4
}
template <int KB>
__device__ __forceinline__ void qkt(f32x16& p0, f32x16& p1, const char* lds, int r32, int hi, const bf16x8* qr) {
    p0 = f32x16{}; p1 = f32x16{};
    const char* kb[4]; const char* kr[4];
#pragma unroll
    for (int dd = 0; dd < 4; ++dd) { kb[dd] = lds + OFF_K + KB * SHM_K + KSWZ(r32, (dd * 16 + hi * 8) * 2); kr[dd] = lds + OFF_R + KB * SHM_R + RSWZ(r32, (dd * 16 + hi * 8) * 2); }
#pragma unroll
    for (int d0 = 0; d0 < 8; ++d0) { const char* a = kb[d0 & 3] + (d0 >> 2) * 128;
        bf16x8 b0 = *reinterpret_cast<const bf16x8*>(a);
        bf16x8 b1 = *reinterpret_cast<const bf16x8*>(a + 32 * 256);
        p0 = __builtin_amdgcn_mfma_f32_32x32x16_bf16(b0, qr[d0], p0, 0, 0, 0);
        p1 = __builtin_amdgcn_mfma_f32_32x32x16_bf16(b1, qr[d0], p1, 0, 0, 0); }
#pragma unroll
    for (int d0 = 0; d0 < 4; ++d0) { const char* a = kr[d0];
        bf16x8 b0 = *reinterpret_cast<const bf16x8*>(a);
        bf16x8 b1 = *reinterpret_cast<const bf16x8*>(a + 32 * 128);
        p0 = __builtin_amdgcn_mfma_f32_32x32x16_bf16(b0, qr[8 + d0], p0, 0, 0, 0);
        p1 = __builtin_amdgcn_mfma_f32_32x32x16_bf16(b1, qr[8 + d0], p1, 0, 0, 0); }
}
template <int VB>
__device__ __forceinline__ void pv_tile(f32x16* o, int vb0, bf16x8 pa0, bf16x8 pa1, bf16x8 pa2, bf16x8 pa3) {
#define TRRD(dst, off) asm volatile("ds_read_b64_tr_b16 %0, %1 offset:%2" : "=&v"(dst) : "v"(vb0), "i"(off) : "memory")
#define PV_D0(d0) do { s16x4 l0, l1, l2, l3, h0, h1, h2, h3; constexpr int b_ = OFF_V + VB * SHM_V + v_rd_off(d0, 0, 0); \
        TRRD(l0, b_); TRRD(h0, b_ + 2048); TRRD(l1, b_ + 4096); TRRD(h1, b_ + 6144); TRRD(l2, b_ + 8192); TRRD(h2, b_ + 10240); TRRD(l3, b_ + 12288); TRRD(h3, b_ + 14336); \
        asm volatile("s_waitcnt lgkmcnt(0)" ::: "memory"); SBAR();   \
        o[d0] = __builtin_amdgcn_mfma_f32_32x32x16_bf16(pa0, (bf16x8){l0[0], l0[1], l0[2], l0[3], h0[0], h0[1], h0[2], h0[3]}, o[d0], 0, 0, 0);   \
        o[d0] = __builtin_amdgcn_mfma_f32_32x32x16_bf16(pa1, (bf16x8){l1[0], l1[1], l1[2], l1[3], h1[0], h1[1], h1[2], h1[3]}, o[d0], 0, 0, 0);   \
        o[d0] = __builtin_amdgcn_mfma_f32_32x32x16_bf16(pa2, (bf16x8){l2[0], l2[1], l2[2], l2[3], h2[0], h2[1], h2[2], h2[3]}, o[d0], 0, 0, 0);   \
        o[d0] = __builtin_amdgcn_mfma_f32_32x32x16_bf16(pa3, (bf16x8){l3[0], l3[1], l3[2], l3[3], h3[0], h3[1], h3[2], h3[3]}, o[d0], 0, 0, 0); } while (0)
    PV_D0(0); PV_D0(1); PV_D0(2); PV_D0(3);
#undef PV_D0
#undef TRRD
}
constexpr int OFF_CONV = 86016, CONV_BUF = 16384  , CONV_NB = 2 * EXD / 32  , CONV_KSTRIDE = 128 * 2 * EXD * 4  ;
struct Conv { const float* src; unsigned char* dst; int cs, G, bx, cb, pend; };
struct ConvLane { unsigned voff0, voff1, ldsE, ldsO, dstoff, sel; };
__device__ __forceinline__ ConvLane conv_lane(int wid, int lane) {
    ConvLane cl; const int kg = lane & 15, q = lane >> 4, hh = (lane >> 3) & 1;
    cl.voff0 = (unsigned)(((wid * 16 + (lane >> 3)) * (2 * EXD) + (((lane & 7) ^ ((wid * 2) & 7)) * 4)) * 4);
    cl.voff1 = (unsigned)(((wid * 16 + 8 + (lane >> 3)) * (2 * EXD) + (((lane & 7) ^ ((wid * 2 + 1) & 7)) * 4)) * 4);
    const int base = OFF_CONV + kg * 1024 + ((wid ^ (kg & 7)) * 16) + q * 4;
    cl.ldsE = (unsigned)(base + hh * 128); cl.ldsO = (unsigned)(base - hh * 128);
    cl.dstoff = (unsigned)((4 * wid + q) * D + 8 * kg);
    cl.sel = hh ? 0x02030001u : 0x03020100u;
    asm volatile("" : "+v"(cl.voff0), "+v"(cl.voff1), "+v"(cl.ldsE), "+v"(cl.ldsO), "+v"(cl.dstoff), "+v"(cl.sel));
    return cl;
}
__device__ __forceinline__ bool conv_valid(const Conv& cv, int q) { return cv.bx + (q >> 6) * cv.G < CONV_NB; }
__device__ __forceinline__ void conv_issue(const Conv& cv, const ConvLane& cl, int q, int buf, LAS unsigned char* ldsl, int wid) {
    const unsigned nbi = (unsigned)(cv.bx + (q >> 6) * cv.G), sk = (unsigned)(q & 63);
    const char* s0 = (const char*)cv.src + ((size_t)sk * CONV_KSTRIDE + nbi * 128);
    __builtin_amdgcn_global_load_lds((const unsigned*)(s0 + cl.voff0), (LAS unsigned*)(ldsl + OFF_CONV + buf * CONV_BUF + wid * 2048), 16, 0, 2);
    __builtin_amdgcn_global_load_lds((const unsigned*)(s0 + cl.voff1), (LAS unsigned*)(ldsl + OFF_CONV + buf * CONV_BUF + wid * 2048 + 1024), 16, 0, 2);
}
struct ConvRegs { float a0, a1, a2, a3, b0, b1, b2, b3; };
__device__ __forceinline__ void conv_load(ConvRegs& r, const ConvLane& cl, int buf, LAS unsigned char* ldsl) {
    const LAS float* pE = (const LAS float*)(ldsl + buf * CONV_BUF + cl.ldsE); const LAS float* pO = (const LAS float*)(ldsl + buf * CONV_BUF + cl.ldsO);
    r.a0 = pE[0]; r.a1 = pE[64]; r.a2 = pE[128]; r.a3 = pE[192]; r.b0 = pO[32]; r.b1 = pO[96]; r.b2 = pO[160]; r.b3 = pO[224];
}
__device__ __forceinline__ void conv_finish(const ConvRegs& r, const Conv& cv, const ConvLane& cl, int q) {
    const unsigned nbi = (unsigned)(cv.bx + (q >> 6) * cv.G), sk = (unsigned)(q & 63);
    const unsigned n0 = nbi * 32, up = (n0 >= (unsigned)EXD) ? 1u : 0u, n1 = n0 - up * EXD, drow0 = (n1 >> 7) * 256 + (n1 & 127) + up * 128;
    const unsigned lo = pk4_fp8(r.a0 * MOE_SC_IN, r.b0 * MOE_SC_IN, r.a1 * MOE_SC_IN, r.b1 * MOE_SC_IN), hi2 = pk4_fp8(r.a2 * MOE_SC_IN, r.b2 * MOE_SC_IN, r.a3 * MOE_SC_IN, r.b3 * MOE_SC_IN);
    u32x2 o; o.x = __builtin_amdgcn_perm(lo, lo, cl.sel); o.y = __builtin_amdgcn_perm(hi2, hi2, cl.sel);
    unsigned char* d0 = cv.dst + ((size_t)(sk >> 3) * ((size_t)2 * EXD * D) + (size_t)drow0 * D + (sk & 7) * 128);
    __builtin_nontemporal_store(o, (GAS u32x2*)(d0 + cl.dstoff));
}
__device__ __forceinline__ void conv_tail(const ConvRegs& r, bool have, Conv& cv, const ConvLane& cl, LAS unsigned char* ldsl, int wid) {
    if (have) conv_finish(r, cv, cl, cv.cs);
    const int nb = (cv.cb == 0) ? 2 : cv.cb - 1;
    cv.pend = conv_valid(cv, cv.cs + 2) ? 1 : 0;
    if (cv.pend) conv_issue(cv, cl, cv.cs + 2, nb, ldsl, wid);
    ++cv.cs; cv.cb = (cv.cb == 2) ? 0 : cv.cb + 1;
}
__device__ __forceinline__ void conv_drain(Conv& cv, LAS unsigned char* ldsl) {
    int tid_ = threadIdx.x; asm volatile("" : "+v"(tid_));
    const int wid = __builtin_amdgcn_readfirstlane(tid_ >> 6), lane = tid_ & 63;
    const ConvLane cl = conv_lane(wid, lane);
    while (conv_valid(cv, cv.cs)) { asm volatile("s_waitcnt vmcnt(0)" ::: "memory"); __syncthreads(); ConvRegs r; conv_load(r, cl, cv.cb, ldsl); conv_tail(r, true, cv, cl, ldsl, wid); }
}
template <int QP, int KP>
__device__ __forceinline__ void attn_block(const bf16* Qp, const bf16* Kp, const bf16* Vp, const bf16* Rp, bf16* Op, int P0, const float* cosT, const float* sinT, char* lds, LAS unsigned char* ldsl, Conv& cv) {
    int tid_ = threadIdx.x; asm volatile("" : "+v"(tid_));
    const int tid = tid_, wid = __builtin_amdgcn_readfirstlane(tid >> 6), lane = tid & 63, r32 = lane & 31, hi = lane >> 5;
    const int NT = (P0 + QB) / KVBLK;
    const int qlo = P0 + wid * QBLK, qm = qlo + r32 - 4 * hi;
    float* wsf = (float*)(lds + OFF_WS) + wid * 64; float* li_l = wsf; float* al_l = wsf + 32;
        const int vb0 = (int)(uintptr_t)lds + v_rd_base(lane);
    bf16x8 qr[12];
    { const bf16* qrow = Qp + (size_t)(wid * QBLK + r32) * QP + hi * 8;
#pragma unroll
      for (int d0 = 0; d0 < 12; ++d0) qr[d0] = *reinterpret_cast<const bf16x8*>(qrow + d0 * 16);
      const float* cr = cosT + (size_t)(qlo + r32) * 32 + hi * 8; const float* sn = sinT + (size_t)(qlo + r32) * 32 + hi * 8;
#pragma unroll
      for (int x = 0; x < 2; ++x) { const f32x4 c0 = *(const f32x4*)(cr + x * 16), c1 = *(const f32x4*)(cr + x * 16 + 4), s0 = *(const f32x4*)(sn + x * 16), s1 = *(const f32x4*)(sn + x * 16 + 4);
          const u32x4 a = *reinterpret_cast<const u32x4*>(&qr[8 + x]), b = *reinterpret_cast<const u32x4*>(&qr[10 + x]); u32x4 oa, ob;
#pragma unroll
          for (int e = 0; e < 4; ++e) { const float t1l = bf_lo(a[e]), t1h = bf_hi(a[e]), t2l = bf_lo(b[e]), t2h = bf_hi(b[e]);
              const float cl = (e < 2) ? c0[2 * e] : c1[2 * e - 4], ch = (e < 2) ? c0[2 * e + 1] : c1[2 * e - 3], sl = (e < 2) ? s0[2 * e] : s1[2 * e - 4], sh = (e < 2) ? s0[2 * e + 1] : s1[2 * e - 3];
              oa[e] = cvt_pk_bf16(t1l * cl - t2l * sl, t1h * ch - t2h * sh); ob[e] = cvt_pk_bf16(t1l * sl + t2l * cl, t1h * sh + t2h * ch); }
          qr[8 + x] = *reinterpret_cast<const bf16x8*>(&oa); qr[10 + x] = *reinterpret_cast<const bf16x8*>(&ob); } }
    float m_reg = -1e30f, l_reg = 0; f32x16 o[4] = {};
    int kofs, vofs, rofs;
    { const int L = wid * 1024 + lane * 16;
        { const int row = L >> 8, colB = (L & 255) ^ ((row & 7) << 4); kofs = row * KP + (colB >> 1); }
        { const int sub = L >> 9, kkh = sub >> 2, cblk = sub & 3, w = (L & 511) >> 1, kk = kkh * 8 + (w >> 5), k = (kk & ~0xC) | ((kk & 4) << 1) | ((kk & 8) >> 1); vofs = k * KP + cblk * 32 + (w & 31); }
        { const int row = L >> 7, colB = (L & 127) ^ ((row & 7) << 4); rofs = row * 64 + (colB >> 1); } }
#define SLOAD(k0, bf) do { \
        __builtin_amdgcn_global_load_lds((const unsigned*)(Kp + (size_t)(k0) * KP + kofs), (LAS unsigned*)(ldsl + OFF_K + (bf) * SHM_K + wid * 1024), 16, 0, 0); \
        __builtin_amdgcn_global_load_lds((const unsigned*)(Kp + (size_t)((k0) + 32) * KP + kofs), (LAS unsigned*)(ldsl + OFF_K + (bf) * SHM_K + 8192 + wid * 1024), 16, 0, 0); \
        __builtin_amdgcn_global_load_lds((const unsigned*)(Vp + (size_t)(k0) * KP + vofs), (LAS unsigned*)(ldsl + OFF_V + (bf) * SHM_V + wid * 1024), 16, 0, 0); \
        __builtin_amdgcn_global_load_lds((const unsigned*)(Vp + (size_t)((k0) + 32) * KP + vofs), (LAS unsigned*)(ldsl + OFF_V + (bf) * SHM_V + 8192 + wid * 1024), 16, 0, 0); \
        __builtin_amdgcn_global_load_lds((const unsigned*)(Rp + (size_t)(k0) * 64 + rofs), (LAS unsigned*)(ldsl + OFF_R + (bf) * SHM_R + wid * 1024), 16, 0, 0); } while (0)
#define RESC(a) do { if (__any((a) < 1.f)) { if (hi == 0) al_l[r32] = (a); asm volatile("s_waitcnt lgkmcnt(0)" ::: "memory");              \
                     for (int d_ = 0; d_ < 4; ++d_) for (int r = 0; r < 16; ++r) o[d_][r] *= al_l[crow(r, hi)]; } } while (0)
#define STEP(t, BF) do { const int kb_ = (t) * KVBLK;                                                                            \
        if (CONV_IN_ATTN && (t) > 0 && cv.pend) asm volatile("s_waitcnt vmcnt(2)" ::: "memory"); else asm volatile("s_waitcnt vmcnt(0)" ::: "memory");       \
        asm volatile("s_waitcnt lgkmcnt(0)" ::: "memory"); __builtin_amdgcn_s_barrier(); asm volatile("" ::: "memory");     \
        if ((t) + 1 < NT) SLOAD(kb_ + KVBLK, 1 - (BF));                                                                         \
        const bool chave_ = CONV_IN_ATTN && conv_valid(cv, cv.cs);                                                                \
        if (kb_ <= qlo + QBLK - 1) { f32x16 p0, p1; float mn, al; bf16x8 pa0, pa1, pa2, pa3;                                     \
            qkt<BF>(p0, p1, lds, r32, hi, qr);                                                                                   \
            if (kb_ + KVBLK - 1 > qlo) mask_tile(p0, p1, qm - kb_);                                                              \
            partialSM(p0, p1, m_reg, mn, al); RESC(al);                                                                          \
            finishSM(p0, p1, al, l_reg, pa0, pa1, pa2, pa3); SBAR();                                                             \
            pv_tile<BF>(o, vb0, pa0, pa1, pa2, pa3); }                                                                           \
        if (CONV_IN_ATTN) { ConvRegs cr_; if (chave_) conv_load(cr_, cl, cv.cb, ldsl); conv_tail(cr_, chave_, cv, cl, ldsl, wid); } } while (0)
    __syncthreads();
    SLOAD(0, 0);
    const ConvLane cl = conv_lane(wid, lane);
    if (CONV_IN_ATTN && cv.cs == 0) { if (conv_valid(cv, 0)) conv_issue(cv, cl, 0, 0, ldsl, wid); if (conv_valid(cv, 1)) conv_issue(cv, cl, 1, 1, ldsl, wid); }
    for (int t = 0; t < NT; t += 2) { STEP(t, 0); STEP(t + 1, 1); }
    if (hi == 0) li_l[r32] = l_reg; asm volatile("s_waitcnt lgkmcnt(0)" ::: "memory");
    bf16* Ow = Op + (size_t)(wid * QBLK) * D;
#pragma unroll
    for (int r = 0; r < 16; ++r) { const int orow = crow(r, hi); const float rl = __builtin_amdgcn_rcpf(li_l[orow]);
#pragma unroll
        for (int d0 = 0; d0 < 4; ++d0) { const float v = o[d0][r] * rl; const float vn = __shfl_xor(v, 1);
            if ((r32 & 1) == 0) *(unsigned*)(Ow + (size_t)orow * D + d0 * 32 + r32) = cvt_pk_bf16(v, vn); } }
#undef SLOAD
#undef RESC
#undef STEP
}
}

#define XB_TMO      128
#define XB_XCNT(j)  (256  + 64 * (j))
#define XB_XSUB(j)  (1280 + 64 * (j))
#define XB_XGEN(j)  (2304 + 64 * (j))
#define XB_TOP      3328
#define XB_TOPGEN   3392
#define XCD_BAR_WORDS 3456
#define XB_SPIN_CAP (1u << 22)
__device__ __forceinline__ unsigned xb_ld(unsigned* p)              { return __hip_atomic_load(p, __ATOMIC_RELAXED, __HIP_MEMORY_SCOPE_AGENT); }
__device__ __forceinline__ unsigned xb_add(unsigned* p, unsigned v) { return __hip_atomic_fetch_add(p, v, __ATOMIC_RELAXED, __HIP_MEMORY_SCOPE_AGENT); }
__device__ __forceinline__ unsigned xb_xcc_id() { return (unsigned)__builtin_amdgcn_s_getreg((3 << 11) | 20) & 0xFu; }
#define XB_SPIN(cond, bar) do { unsigned _sp = 0; while (cond) { __builtin_amdgcn_s_sleep(1); \
    if ((++_sp & 255u) == 0u) { if (xb_ld(&(bar)[XB_TMO])) break; if (_sp > XB_SPIN_CAP) { atomicAdd(&(bar)[XB_TMO], 1u); break; } } } } while (0)
struct XcdBarrier { unsigned* bar; unsigned x; volatile LAS unsigned* st; };
__device__ __forceinline__ XcdBarrier xcd_barrier_post(unsigned* bar, volatile LAS unsigned* st) {
    XcdBarrier b; b.bar = bar; b.x = xb_xcc_id(); b.st = st;
    if (threadIdx.x == 0) (void)xb_add(&bar[XB_XCNT(b.x)], 1u);
    return b;
}
__device__ __forceinline__ void xcd_barrier_complete(unsigned* bar, unsigned x, unsigned& nloc, unsigned& nx) {
    const unsigned G = gridDim.x * gridDim.y * gridDim.z;
    unsigned sum, cnt, mine, sp = 0u;
    for (;;) {
        sum = 0u; cnt = 0u; mine = 0u;
#pragma unroll
        for (unsigned j = 0; j < 16; ++j) { const unsigned c = xb_ld(&bar[XB_XCNT(j)]); sum += c; cnt += (c > 0u) ? 1u : 0u; mine = (j == x) ? c : mine; }
        if (sum == G) break;
        __builtin_amdgcn_s_sleep(1);
        if ((++sp & 255u) == 0u) { if (xb_ld(&bar[XB_TMO])) break; if (sp > XB_SPIN_CAP) { atomicAdd(&bar[XB_TMO], 1u); break; } }
    }
    nloc = mine > 0u ? mine : 1u; nx = cnt > 0u ? cnt : 1u;
}
__device__ __forceinline__ void xcd_barrier(const XcdBarrier& b) {
    asm volatile("s_waitcnt vmcnt(0)" ::: "memory");
    __syncthreads();
    if (threadIdx.x == 0) {
        unsigned* bar = b.bar;
        __builtin_amdgcn_s_waitcnt(0);
        unsigned nloc = b.st[0], nx = b.st[1];
        if (nloc == 0u) { xcd_barrier_complete(bar, b.x, nloc, nx); b.st[0] = nloc; b.st[1] = nx; }
        const unsigned old = xb_add(&bar[XB_XSUB(b.x)], 1u);
        const unsigned gen = old / nloc;
        if (old + 1u == (gen + 1u) * nloc) {
            __builtin_amdgcn_fence(__ATOMIC_RELEASE, "agent");
            asm volatile("s_waitcnt vmcnt(0)" ::: "memory");
            const unsigned og = xb_add(&bar[XB_TOP], 1u);
            const unsigned tg = og / nx;
            if (og + 1u == (tg + 1u) * nx) xb_add(&bar[XB_TOPGEN], 1u);
            else XB_SPIN(xb_ld(&bar[XB_TOPGEN]) == tg, bar);
            __builtin_amdgcn_fence(__ATOMIC_ACQUIRE, "agent");
            xb_add(&bar[XB_XGEN(b.x)], 1u);
            asm volatile("s_waitcnt vmcnt(0)" ::: "memory");
        } else {
            XB_SPIN(xb_ld(&bar[XB_XGEN(b.x)]) == gen, bar);
            __builtin_amdgcn_fence(__ATOMIC_ACQUIRE, "agent");
            asm volatile("s_waitcnt vmcnt(0)" ::: "memory");
        }
    }
    __syncthreads();
}

struct Args { const float* in[24]; float* out; unsigned char* ws; int ph_lo, ph_hi, li, pad; };
enum In { I_X = 0, I_LAMRE, I_LAMIM, I_LOGSTEP, I_BRE, I_BIM, I_CRE, I_CIM, I_SD, I_WGLU, I_QWA, I_QNORM, I_QWB, I_OW, I_KVWA, I_KVNORM, I_KVWB, I_FFNIN, I_FFNOUT, I_ROUTER, I_MOEIN, I_MOEOUT, I_LNG, I_LNB };

__device__ __forceinline__ void tr_item(const float* W, int N, bf16* WT, int ldk, int k0, int n0, int drow0, int dk0, LAS float* scr, int lane) {
    { const int r4 = lane >> 4, c4 = (lane & 15) * 4;
      f32x4 v[16];
#pragma unroll
      for (int i = 0; i < 16; ++i) v[i] = __builtin_nontemporal_load((const GAS f32x4*)(W + (size_t)(k0 + 4 * i + r4) * N + n0 + c4));
#pragma unroll
      for (int i = 0; i < 16; ++i) { LAS float* d = scr + (4 * i + r4) * 65 + c4; d[0] = v[i][0]; d[1] = v[i][1]; d[2] = v[i][2]; d[3] = v[i][3]; } }
    LDS_WAIT(); asm volatile("" ::: "memory");
    const int c = lane & 7;
#pragma unroll
    for (int jj = 0; jj < 8; ++jj) { const int n = (lane >> 3) + 8 * jj; const LAS float* s = scr + (8 * c) * 65 + n;
        u32x4 o; o.x = cvt_pk_bf16(s[0 * 65], s[1 * 65]); o.y = cvt_pk_bf16(s[2 * 65], s[3 * 65]); o.z = cvt_pk_bf16(s[4 * 65], s[5 * 65]); o.w = cvt_pk_bf16(s[6 * 65], s[7 * 65]);
        __builtin_nontemporal_store(o, (GAS u32x4*)(WT + (size_t)(drow0 + n) * ldk + dk0 + k0 + 8 * c)); }
    LDS_WAIT(); asm volatile("" ::: "memory");
}
__device__ __forceinline__ void tr_item8(const float* W, int N, fp8* WT, int ldk, int k0, int n0, int drow0, float sc, LAS float* scr, int lane) {
    { const int r4 = lane >> 4, c4 = (lane & 15) * 4;
      f32x4 v[16];
#pragma unroll
      for (int i = 0; i < 16; ++i) v[i] = __builtin_nontemporal_load((const GAS f32x4*)(W + (size_t)(k0 + 4 * i + r4) * N + n0 + c4));
#pragma unroll
      for (int i = 0; i < 16; ++i) { LAS float* d = scr + (4 * i + r4) * 65 + c4; d[0] = v[i][0] * sc; d[1] = v[i][1] * sc; d[2] = v[i][2] * sc; d[3] = v[i][3] * sc; } }
    LDS_WAIT(); asm volatile("" ::: "memory");
    const int c = lane & 3;
#pragma unroll
    for (int jj = 0; jj < 4; ++jj) { const int n = (lane >> 2) + 16 * jj; const LAS float* s = scr + (16 * c) * 65 + n;
        u32x4 o; o.x = pk4_fp8(s[0 * 65], s[1 * 65], s[2 * 65], s[3 * 65]); o.y = pk4_fp8(s[4 * 65], s[5 * 65], s[6 * 65], s[7 * 65]);
        o.z = pk4_fp8(s[8 * 65], s[9 * 65], s[10 * 65], s[11 * 65]); o.w = pk4_fp8(s[12 * 65], s[13 * 65], s[14 * 65], s[15 * 65]);
        __builtin_nontemporal_store(o, (GAS u32x4*)(WT + (size_t)(drow0 + n) * ldk + k0 + 16 * c)); }
    LDS_WAIT(); asm volatile("" ::: "memory");
}
__device__ __forceinline__ void tr_matrix_item8(const float* W, int N, fp8* WT, int ldk, int ilv, float sc, LAS float* scr, int item, int lane) {
    const int nb = N / 64, kb = item / nb, nbi = item % nb, n0 = nbi * 64;
    int drow = n0;
    if (ilv > 0) { const int n1 = (n0 >= ilv) ? n0 - ilv : n0; drow = (n1 >> 7) * 256 + (n1 & 127) + ((n0 >= ilv) ? 128 : 0); }
    tr_item8(W, N, WT, ldk, kb * 128, n0, drow, sc, scr, lane); tr_item8(W, N, WT, ldk, kb * 128 + 64, n0, drow, sc, scr, lane);
}
__device__ __forceinline__ void tr_matrix_item(const float* W, int K, int N, bf16* WT, int ldk, int drow_base, int dk0, int ilv, LAS float* scr, int item, int lane) {
    const int nb = N / 64, kb = item / nb, nbi = item % nb, n0 = nbi * 64; (void)K;
    int drow = n0;
    if (ilv > 0) { const int n1 = (n0 >= ilv) ? n0 - ilv : n0; drow = (n1 >> 7) * 256 + (n1 & 127) + ((n0 >= ilv) ? 128 : 0); }
    tr_item(W, N, WT, ldk, kb * 64, n0, drow_base + drow, dk0, scr, lane);
}

__global__ void __launch_bounds__(NWAVES * 64, 2) yoco_fwd(Args args) {
    extern __shared__ __attribute__((aligned(16))) unsigned char lds_raw[];
    LAS unsigned char* lds = (LAS unsigned char*)lds_raw;
    volatile LAS unsigned* MISC = (volatile LAS unsigned*)(lds + MISC_OFF);
    const int G = gridDim.x; const int bx = blockIdx.x; const int vcu = (G % 8 == 0) ? (bx % 8) * (G / 8) + bx / 8 : bx;
    const int NGW = G * NWAVES;
#define PHASE_IDS() int tid = threadIdx.x; asm volatile("" : "+v"(tid)); const int lane = tid & 63, wave = __builtin_amdgcn_readfirstlane(tid >> 6); const int gw = vcu * NWAVES + wave; (void)gw; (void)lane
    unsigned char* ws = args.ws;
    GAS unsigned* ctl = (GAS unsigned*)(ws + WS_CTL);
    for (int u = threadIdx.x; u < (LDS_BYTES - LDSCTL_OFF) / 4; u += NWAVES * 64) ((LAS unsigned*)(lds + LDSCTL_OFF))[u] = 0u;
    __syncthreads();
    XcdBarrier bar; bar.bar = (unsigned*)(ws + WS_CTL) + CW_BAR; bar.x = 0; bar.st = nullptr;
    if (MK_N_LAUNCHES == 1) bar = xcd_barrier_post((unsigned*)(ws + WS_CTL) + CW_BAR, MISC + 8);
#define GRID_BAR() do { if (MK_N_LAUNCHES == 1) xcd_barrier(bar); } while (0)
    const int lo = args.ph_lo, hi_ph = args.ph_hi;
#ifndef PH_MASK
#define PH_MASK 0x3ffffff
#endif
#define IN(k) (((PH_MASK >> (k)) & 1) && lo <= (k) && (k) < hi_ph)
#define BOTH(k) (IN(k) && IN((k) + 1))

    const float* x_in = args.in[I_X];
    bf16* W_MOEIN = (bf16*)(ws + WS_MOEIN); bf16* W_MOEOUT = (bf16*)(ws + WS_MOEOUT); bf16* W_FFNIN = (bf16*)(ws + WS_FFNIN); bf16* W_FFNOUT = (bf16*)(ws + WS_FFNOUT);
    bf16* W_GLU = (bf16*)(ws + WS_GLU); bf16* W_OW = (bf16*)(ws + WS_OW); bf16* W_QKVB = (bf16*)(ws + WS_QKVB); bf16* W_QKVA = (bf16*)(ws + WS_QKVA);
    bf16* W_S5ST = (bf16*)(ws + WS_S5ST); bf16* W_S5W3 = (bf16*)(ws + WS_S5W3);
    float* ROPE_C = (float*)(ws + WS_ROPE); float* ROPE_S = ROPE_C + SEQ * 32;
    float* PTAB = (float*)(ws + WS_PTAB); float* BBTAB = (float*)(ws + WS_BBTAB);
    bf16* A3 = (bf16*)(ws + WS_A3); float* SEND = (float*)(ws + WS_SEND); bf16* ACT = (bf16*)(ws + WS_ACT); bf16* Hb = (bf16*)(ws + WS_H);
    bf16* X1 = (bf16*)(ws + WS_X1); bf16* FFNH = (bf16*)(ws + WS_FFNH); bf16* X2 = (bf16*)(ws + WS_X2); float* QKVAF = (float*)(ws + WS_QKVAF);
    bf16* CQKV = (bf16*)(ws + WS_CQKV); bf16* KROPE = (bf16*)(ws + WS_KROPE); bf16* QKV = (bf16*)(ws + WS_QKV); bf16* H3b = (bf16*)(ws + WS_H3);
    bf16* OB = (bf16*)(ws + WS_O); bf16* X3 = (bf16*)(ws + WS_X3); bf16* MOEH = (bf16*)(ws + WS_MOEH); fp8* X3Q = (fp8*)(ws + WS_MOEH + 232 * MiB); (void)X3Q; float* YSLAB = (float*)(ws + WS_MOEH + 264 * MiB); (void)YSLAB;   bf16* YB = (bf16*)(ws + WS_Y);
    int* ROW_TOK = (int*)(ws + WS_ROUTE); int* TOK_INFO = (int*)(ws + WS_ROUTE + 1 * MiB); float* GATES = (float*)(ws + WS_ROUTE + 1 * MiB + 512 * 1024);

    if (IN(0) || IN(18) || IN(19) || IN(20)) {
        PHASE_IDS();
        LAS float* scr = (LAS float*)(lds + RING_OFF + wave * 16640);
        constexpr int I_GLU = 16 * 32, I_FIN = 16 * 88, I_FOUT = (FFN_DOWN_FP8 ? 22 : 44) * 16, I_QA = 16 * 4, I_KVA = 16 * 3, I_O = MLA_ABSORB ? 0 : 16 * 16, I_QB = MLA_ABSORB ? 0 : 4 * 24, I_KVB = MLA_ABSORB ? 0 : 2 * 32, I_MIN = (MOE_FP8 ? (CONV_IN_ATTN ? 0 : 8) : 16) * 112, I_MOUT = (MOE_FP8 ? 28 : 56) * 16;
        constexpr int NITEMS = I_GLU + I_FIN + I_FOUT + I_QA + I_KVA + I_O + I_QB + I_KVB + NEXP * (I_MIN + (MOE_FP8 ? 0 : I_MOUT));
        if (IN(0) || IN(18))
        for (int it = gw; it < NITEMS; it += NGW) {
            int r = it;
            if (r < I_GLU) { tr_matrix_item(args.in[I_WGLU], D, 2 * D, W_GLU, D, 0, 0, D, scr, r, lane); continue; } r -= I_GLU;
            if (r < I_FIN) { tr_matrix_item(args.in[I_FFNIN], D, 2 * FFN, W_FFNIN, D, 0, 0, FFN, scr, r, lane); continue; } r -= I_FIN;
#if FFN_DOWN_FP8
            if (r < I_FOUT) { tr_matrix_item8(args.in[I_FFNOUT], D, (fp8*)W_FFNOUT, FFN, 0, MOE_SC_OUT, scr, r, lane); continue; } r -= I_FOUT;
#else
            if (r < I_FOUT) { tr_matrix_item(args.in[I_FFNOUT], FFN, D, W_FFNOUT, FFN, 0, 0, 0, scr, r, lane); continue; } r -= I_FOUT;
#endif
            if (r < I_QA) { tr_matrix_item(args.in[I_QWA], D, QL, W_QKVA, D, 0, 0, 0, scr, r, lane); continue; } r -= I_QA;
            if (r < I_KVA) { tr_matrix_item(args.in[I_KVWA], D, KVL + QKR, W_QKVA, D, QL, 0, 0, scr, r, lane); continue; } r -= I_KVA;
#if !MLA_ABSORB
            if (r < I_O) { tr_matrix_item(args.in[I_OW], D, D, W_OW, D, 0, 0, 0, scr, r, lane); continue; } r -= I_O;
            if (r < I_QB) { tr_matrix_item(args.in[I_QWB], QL, QW, W_QKVB, QKVB_K, 0, 0, 0, scr, r, lane); continue; } r -= I_QB;
            if (r < I_KVB) { tr_matrix_item(args.in[I_KVWB], KVL, HEADS * (QKN + VD), W_QKVB, QKVB_K, QW, QL, 0, scr, r, lane); continue; } r -= I_KVB;
#endif
#if MOE_FP8 && CONV_IN_ATTN
            (void)r;
#elif MOE_FP8
            { const int e = r / I_MIN; tr_matrix_item8(args.in[I_MOEIN] + (size_t)e * D * 2 * EXD, 2 * EXD, (fp8*)W_MOEIN + (size_t)e * 2 * EXD * D, D, EXD, MOE_SC_IN, scr, r % I_MIN, lane); }
#else
            if (r < NEXP * I_MIN) { const int e = r / I_MIN; tr_matrix_item(args.in[I_MOEIN] + (size_t)e * D * 2 * EXD, D, 2 * EXD, W_MOEIN + (size_t)e * 2 * EXD * D, D, 0, 0, EXD, scr, r % I_MIN, lane); continue; } r -= NEXP * I_MIN;
            { const int e = r / I_MOUT; tr_matrix_item(args.in[I_MOEOUT] + (size_t)e * EXD * D, EXD, D, W_MOEOUT + (size_t)e * D * EXD, EXD, 0, 0, 0, scr, r % I_MOUT, lane); }
#endif
        }
        if (IN(0) || IN(19)) { const u32x4 z = {0u, 0u, 0u, 0u}; const size_t gt = (size_t)gw * 64 + lane, GT = (size_t)NGW * 64;
          for (size_t i = gt; i < (size_t)64 * D / 8; i += GT) *(GAS u32x4*)(W_QKVA + (size_t)448 * D + i * 8) = z;
#if !MLA_ABSORB
          for (size_t i = gt; i < (size_t)QW * 16; i += GT) { const size_t row = i / 16, ch = i % 16; *(GAS u32x4*)(W_QKVB + row * QKVB_K + QL + ch * 8) = z; }
          for (size_t i = gt; i < (size_t)2048 * 32; i += GT) { const size_t row = i / 32, ch = i % 32; *(GAS u32x4*)(W_QKVB + (QW + row) * QKVB_K + ch * 8) = z; }
#endif
          for (size_t i = gt; i < (size_t)S5G * 128 * 32; i += GT) { const size_t g = i / (128 * 32), rem = i % (128 * 32); *(GAS u32x4*)(W_S5ST + (g * 256 + 128) * 256 + rem * 8) = z; } }
        if (IN(0) || IN(19))
        for (int i = gw * 64 + lane; i < SEQ * 32; i += NGW * 64) { const int pos = i >> 5, f = i & 31; const float inv = powf(10000.0f, -(float)(2 * f) / 64.0f); const float ang = (float)pos * inv; float s, c; sincosf(ang, &s, &c); ROPE_C[i] = c; ROPE_S[i] = s; }
        if (IN(0) || IN(19))
        for (int i = gw * 64 + lane; i < S5G * S5P * 16; i += NGW * 64) {
            const int k = i & 15, gn = i >> 4, g = gn >> 6, n = gn & 63;
            const float lr = args.in[I_LAMRE][gn], li = args.in[I_LAMIM][gn], dt = expf(args.in[I_LOGSTEP][g]);
            const float mag = expf(lr * dt); float sn, cs; sincosf(li * dt, &sn, &cs); const float lbr = mag * cs, lbi = mag * sn;
            const float den = lr * lr + li * li, fre = ((lbr - 1.0f) * lr + lbi * li) / den, fim = (lbi * lr - (lbr - 1.0f) * li) / den;
            float pr = 1.f, pi = 0.f, pkr = 1.f, pki = 0.f, pwr = 1.f, pwi = 0.f;
#pragma unroll
            for (int d = 1; d <= 16; ++d) { const float nr = pr * lbr - pi * lbi, ni = pr * lbi + pi * lbr; pr = nr; pi = ni; if (d == k) { pkr = pr; pki = pi; } if (d == 15 - k) { pwr = pr; pwi = pi; } }
            *(GAS f32x2*)(PTAB + ((size_t)gn * 17 + k) * 2) = (f32x2){pkr, pki};
            if (k == 15) *(GAS f32x2*)(PTAB + ((size_t)gn * 17 + 16) * 2) = (f32x2){pr, pi};
            const float* brp = args.in[I_BRE] + (size_t)gn * 16; const float* bip = args.in[I_BIM] + (size_t)gn * 16;
            float bbr[16], bbi[16];
#pragma unroll
            for (int q = 0; q < 4; ++q) { const f32x4 br = *(const GAS f32x4*)(brp + 4 * q), bi = *(const GAS f32x4*)(bip + 4 * q);
#pragma unroll
                for (int e = 0; e < 4; ++e) { bbr[4 * q + e] = fre * br[e] - fim * bi[e]; bbi[4 * q + e] = fre * bi[e] + fim * br[e]; } }
            { float mr = 0.f, mi = 0.f;
#pragma unroll
              for (int ch = 0; ch < 16; ++ch) { mr = (ch == k) ? bbr[ch] : mr; mi = (ch == k) ? bbi[ch] : mi; }
              *(GAS f32x2*)(BBTAB + ((size_t)gn * 16 + k) * 2) = (f32x2){mr, mi}; }
            bf16* wre = W_S5ST + ((size_t)g * 256 + n) * 256 + k * 16; bf16* wim = W_S5ST + ((size_t)g * 256 + 64 + n) * 256 + k * 16;
            u32x4 a0, a1, b0, b1;
#pragma unroll
            for (int e = 0; e < 4; ++e) { const int c0 = 2 * e, c1 = 2 * e + 1;
                a0[e] = cvt_pk_bf16(pwr * bbr[c0] - pwi * bbi[c0], pwr * bbr[c1] - pwi * bbi[c1]); a1[e] = cvt_pk_bf16(pwr * bbr[8 + c0] - pwi * bbi[8 + c0], pwr * bbr[8 + c1] - pwi * bbi[8 + c1]);
                b0[e] = cvt_pk_bf16(pwr * bbi[c0] + pwi * bbr[c0], pwr * bbi[c1] + pwi * bbr[c1]); b1[e] = cvt_pk_bf16(pwr * bbi[8 + c0] + pwi * bbr[8 + c0], pwr * bbi[8 + c1] + pwi * bbr[8 + c1]); }
            *(GAS u32x4*)(wre) = a0; *(GAS u32x4*)(wre + 8) = a1; *(GAS u32x4*)(wim) = b0; *(GAS u32x4*)(wim + 8) = b1;
        }
        __syncthreads();
        if (IN(0) || IN(20)) {
            LAS unsigned char* tile = lds + RING_OFF;
            f32x4 v[2][4];
#define A3_LOAD(bc_) do { _Pragma("unroll") for (int t = 0; t < 2; ++t) _Pragma("unroll") for (int q = 0; q < 4; ++q) v[t][q] = __builtin_nontemporal_load((const GAS f32x4*)(x_in + ((size_t)(bc_) * LCH + 2 * wave + t) * D + q * 256 + 4 * lane)); } while (0)
            int bc = vcu;
            if (bc < NBC) A3_LOAD(bc);
            for (; bc < NBC; bc += G) {
#pragma unroll
                for (int t = 0; t < 2; ++t)
#pragma unroll
                    for (int q = 0; q < 4; ++q) { u32x2 w; w.x = cvt_pk_bf16(v[t][q][0], v[t][q][1]); w.y = cvt_pk_bf16(v[t][q][2], v[t][q][3]); *(LAS u32x2*)(tile + (2 * wave + t) * 2080 + (q * 256 + 4 * lane) * 2) = w; }
                if (bc + G < NBC) A3_LOAD(bc + G);
                LDS_WAIT(); __builtin_amdgcn_s_barrier(); asm volatile("" ::: "memory");
                const int t32 = lane & 31, j = t32 >> 1, half = t32 & 1;
#pragma unroll
                for (int i2 = 0; i2 < 4; ++i2) { const int g = 8 * wave + 2 * i2 + (lane >> 5); const u32x4 w = *(const LAS u32x4*)(tile + j * 2080 + g * 32 + half * 16);
                    __builtin_nontemporal_store(w, (GAS u32x4*)(A3 + ((size_t)g * NBC + bc) * A3_LD + j * 16 + half * 8)); }
                LDS_WAIT(); __builtin_amdgcn_s_barrier(); asm volatile("" ::: "memory");
            }
#undef A3_LOAD
        }
        if (BOTH(0)) GRID_BAR();
    }

    if (IN(1)) {
        pg8::GroupSched S{(const char*)A3, (const char*)W_S5ST, G, bx, (size_t)NBC * A3_LD * 2, (size_t)256 * 256 * 2, (size_t)256 * A3_LD * 2, 4};
        pg8::EpiS1 E{SEND};
        pg8::gemm_phase<pg8::EpiS1, pg8::GroupSched, false>(lds + RING_OFF, 256 * 2, A3_LD * 2, S, E);
        if (BOTH(1)) GRID_BAR();
    }

    if (IN(2) || IN(21) || IN(22) || IN(23) || IN(24)) {
        PHASE_IDS();
#if MLA_ABSORB
        if (IN(2) || IN(21))
        { LAS float* TA = (LAS float*)(lds + RING_OFF); LAS float* TB = TA + 128 * 132;
          for (int it2 = vcu; it2 < 160; it2 += G) {
              const int it = it2 >> 1, half = it2 & 1;
              const bool tq = it < 16; const int h = tq ? (it >> 1) : ((it - 16) >> 3), sb = tq ? (it & 1) : ((it - 16) & 7);
              const float* srcI = tq ? args.in[I_QWB] + (size_t)(sb * 128) * QW + h * (QKN + QKR) : args.in[I_KVWB] + h * (QKN + VD) + QKN; const int pI = tq ? QW : HEADS * (QKN + VD);
#pragma unroll
              for (int q = 0; q < 8; ++q) { const int idx = tid + 512 * q, row = idx >> 5, c4 = (idx & 31) * 4; *(LAS f32x4*)(TA + row * 132 + c4) = *(const GAS f32x4*)(srcI + (size_t)row * pI + c4); }
              if (tq) { const float* srcN = args.in[I_KVWB] + (size_t)(half * 64) * (HEADS * (QKN + VD)) + h * (QKN + VD);
#pragma unroll
                  for (int q = 0; q < 4; ++q) { const int idx = tid + 512 * q, row = idx >> 5, c4 = (idx & 31) * 4; *(LAS f32x4*)(TB + row * 132 + c4) = *(const GAS f32x4*)(srcN + (size_t)row * (HEADS * (QKN + VD)) + c4); }
              } else { const float* srcN = args.in[I_OW] + (size_t)(h * VD) * D + sb * 128 + half * 64;
#pragma unroll
                  for (int q = 0; q < 4; ++q) { const int idx = tid + 512 * q, dr = idx >> 4, n4 = (idx & 15) * 4; const f32x4 v = *(const GAS f32x4*)(srcN + (size_t)dr * D + n4);
                      TB[(n4 + 0) * 132 + dr] = v[0]; TB[(n4 + 1) * 132 + dr] = v[1]; TB[(n4 + 2) * 132 + dr] = v[2]; TB[(n4 + 3) * 132 + dr] = v[3]; } }
              LDS_WAIT(); __syncthreads();
              const int r32 = lane & 31, hi = lane >> 5, iblk = wave & 3, nblk = wave >> 2;
              const LAS float* pa = TA + (iblk * 32 + r32) * 132 + 4 * hi; const LAS float* pb = TB + (nblk * 32 + r32) * 132 + 4 * hi;
              f32x16 acc = {};
#pragma unroll 4
              for (int m = 0; m < 16; ++m) { const f32x4 av = *(const LAS f32x4*)(pa + 8 * m), bv = *(const LAS f32x4*)(pb + 8 * m);
#pragma unroll
                  for (int e = 0; e < 4; ++e) acc = __builtin_amdgcn_mfma_f32_32x32x2f32(av[e], bv[e], acc, 0, 0, 0); }
              { const int ng = half * 64 + nblk * 32 + r32;
                bf16* orow = tq ? W_QKVB + (size_t)(h * (QKN + QKR) + ng) * QL + sb * 128 : W_OW + (size_t)(sb * 128 + ng) * D + h * VD;
#pragma unroll
                for (int rq = 0; rq < 4; ++rq) { u32x2 w; w.x = cvt_pk_bf16(acc[4 * rq], acc[4 * rq + 1]); w.y = cvt_pk_bf16(acc[4 * rq + 2], acc[4 * rq + 3]);
                    *(GAS u32x2*)(orow + iblk * 32 + 8 * rq + 4 * hi) = w; } }
              LDS_WAIT(); __syncthreads();
          }
          { LAS float* scr = (LAS float*)(lds + RING_OFF + wave * 16640);
            for (int it = gw; it < HEADS * 4; it += NGW) { const int h = it >> 2, kb = it & 3; tr_item(args.in[I_QWB], QW, W_QKVB, QL, kb * 64, h * (QKN + QKR) + QKN, h * (QKN + QKR) + QKN, 0, scr, lane); } }
          __syncthreads();
        }
#endif
        if (IN(2) || IN(22)) {
        { LAS float* LC = (LAS float*)(lds + RING_OFF);
          LAS float* LP = LC + 2 * 16 * 65 + 16;
          LAS float* LB = LP + 2176;
          for (int it = vcu; it < S5G * 4; it += G) {
              const int g = it >> 2, dq = it & 3;
              { const int half = tid >> 8, t = tid & 255, co_ = t >> 4, c4 = (t & 15) * 4; const f32x4 v = *(const GAS f32x4*)(args.in[half ? I_CIM : I_CRE] + (size_t)g * 1024 + t * 4);
                LAS float* dst = LC + half * (16 * 65) + co_ * 65 + c4; dst[0] = v[0]; dst[1] = v[1]; dst[2] = v[2]; dst[3] = v[3]; }
              for (int i = tid; i < 544; i += 512) *(LAS f32x4*)(LP + i * 4) = *(const GAS f32x4*)(PTAB + (size_t)g * 2176 + i * 4);
              *(LAS f32x4*)(LB + tid * 4) = *(const GAS f32x4*)(BBTAB + (size_t)g * 2048 + tid * 4);
              LDS_WAIT(); __syncthreads();
              { const int sub = tid & 3, cih = (tid >> 2) & 1, co = (tid >> 3) & 15, d = dq * 4 + (tid >> 7);
                float acc8[8];
#pragma unroll
                for (int e = 0; e < 8; ++e) acc8[e] = 0.f;
                for (int n = sub; n < 64; n += 4) {
                    const f32x2 p = *(const LAS f32x2*)(LP + (n * 17 + d) * 2);
                    const float cr = LC[co * 65 + n], ci = LC[16 * 65 + co * 65 + n], cpr = cr * p.x - ci * p.y, cpi = cr * p.y + ci * p.x;
                    const LAS float* bb = LB + (n * 16 + cih * 8) * 2;
                    const f32x4 b0 = *(const LAS f32x4*)(bb), b1 = *(const LAS f32x4*)(bb + 4), b2 = *(const LAS f32x4*)(bb + 8), b3 = *(const LAS f32x4*)(bb + 12);
                    acc8[0] += cpr * b0[0] - cpi * b0[1]; acc8[1] += cpr * b0[2] - cpi * b0[3]; acc8[2] += cpr * b1[0] - cpi * b1[1]; acc8[3] += cpr * b1[2] - cpi * b1[3];
                    acc8[4] += cpr * b2[0] - cpi * b2[1]; acc8[5] += cpr * b2[2] - cpi * b2[3]; acc8[6] += cpr * b3[0] - cpi * b3[1]; acc8[7] += cpr * b3[2] - cpi * b3[3];
                }
#pragma unroll
                for (int e = 0; e < 8; ++e) { acc8[e] += __shfl_xor(acc8[e], 1); acc8[e] += __shfl_xor(acc8[e], 2); }
                if (sub == 0) {
                    if (d == 0) { const float ds = args.in[I_SD][g * 16 + co];
#pragma unroll
                        for (int e = 0; e < 8; ++e) if (cih * 8 + e == co) acc8[e] += ds; }
                    u32x4 w; w.x = cvt_pk_bf16(acc8[0], acc8[1]); w.y = cvt_pk_bf16(acc8[2], acc8[3]); w.z = cvt_pk_bf16(acc8[4], acc8[5]); w.w = cvt_pk_bf16(acc8[6], acc8[7]);
                    const u32x4 z = {0u, 0u, 0u, 0u};
                    bf16* base = W_S5W3 + (size_t)g * 256 * A3_LD + cih * 8;
                    for (int k = 0; k + d < 16; ++k) { const int j = k + d; *(GAS u32x4*)(base + (size_t)(j * 16 + co) * A3_LD + k * 16) = w; if (d > 0) *(GAS u32x4*)(base + (size_t)(k * 16 + co) * A3_LD + j * 16) = z; }
                } }
              { const int no = tid & 7, co = (tid >> 3) & 15, j = dq * 4 + (tid >> 7), row = j * 16 + co;
                float vr[8], vi[8];
#pragma unroll
                for (int e = 0; e < 8; ++e) { const int n = no * 8 + e; const f32x2 p = *(const LAS f32x2*)(LP + (n * 17 + j + 1) * 2);
                    const float cr = LC[co * 65 + n], ci = LC[16 * 65 + co * 65 + n]; vr[e] = cr * p.x - ci * p.y; vi[e] = -(cr * p.y + ci * p.x); }
                u32x4 a, b; a.x = cvt_pk_bf16(vr[0], vr[1]); a.y = cvt_pk_bf16(vr[2], vr[3]); a.z = cvt_pk_bf16(vr[4], vr[5]); a.w = cvt_pk_bf16(vr[6], vr[7]);
                b.x = cvt_pk_bf16(vi[0], vi[1]); b.y = cvt_pk_bf16(vi[2], vi[3]); b.z = cvt_pk_bf16(vi[4], vi[5]); b.w = cvt_pk_bf16(vi[6], vi[7]);
                bf16* rp = W_S5W3 + ((size_t)g * 256 + row) * A3_LD + 256 + no * 8;
                *(GAS u32x4*)(rp) = a; *(GAS u32x4*)(rp + 64) = b; }
              LDS_WAIT(); __syncthreads();
          } }
        }
        if (IN(2) || IN(23) || IN(24)) {
#if MOE_FP8
        if (wave >= 4) {
            LAS float* scr = (LAS float*)(lds + RING_OFF + wave * 16640);
            constexpr int I_MOUT2 = 28 * 16;
            if (!IN(24))
            for (int it = vcu * 4 + (wave - 4); it < NEXP * I_MOUT2; it += G * 4) { const int e = it / I_MOUT2;
                tr_matrix_item8(args.in[I_MOEOUT] + (size_t)e * EXD * D, D, (fp8*)W_MOEOUT + (size_t)e * D * EXD, EXD, 0, MOE_SC_OUT, scr, it % I_MOUT2, lane); }
        } else
        for (int chain = vcu * 4 + wave; chain < S5G * BATCH; chain += G * 4) {
#else
        for (int chain = gw; chain < S5G * BATCH; chain += NGW) {
#endif
            const int g = chain >> 4, b = chain & 15;
            const f32x2 p16 = *(const GAS f32x2*)(PTAB + (((size_t)g * 64 + lane) * 17 + 16) * 2);
            const float* sp = SEND + ((size_t)g * NBC + b * NCHUNK) * 128 + lane; bf16* ap = A3 + ((size_t)g * NBC + b * NCHUNK) * A3_LD + 256 + lane;
            float sr_ = 0.f, si_ = 0.f;
            constexpr int CG = 16;
            float er[CG], ei[CG], fr_[CG], fi_[CG];
#pragma unroll
            for (int q = 0; q < CG; ++q) { er[q] = sp[(size_t)q * 128]; ei[q] = sp[(size_t)q * 128 + 64]; }
            for (int c0 = 0; c0 < NCHUNK; c0 += CG) {
                const int cn = (c0 + CG < NCHUNK) ? c0 + CG : c0;
#pragma unroll
                for (int q = 0; q < CG; ++q) { fr_[q] = sp[(size_t)(cn + q) * 128]; fi_[q] = sp[(size_t)(cn + q) * 128 + 64]; }
#pragma unroll
                for (int q = 0; q < CG; ++q) { ap[(size_t)(c0 + q) * A3_LD] = (bf16)(cvt_pk_bf16(sr_, 0.f) & 0xffffu); ap[(size_t)(c0 + q) * A3_LD + 64] = (bf16)(cvt_pk_bf16(si_, 0.f) & 0xffffu);
                    const float nr = p16.x * sr_ - p16.y * si_ + er[q], ni = p16.x * si_ + p16.y * sr_ + ei[q]; sr_ = nr; si_ = ni; }
#pragma unroll
                for (int q = 0; q < CG; ++q) { er[q] = fr_[q]; ei[q] = fi_[q]; }
            }
        }
        }
        if (BOTH(2)) GRID_BAR();
    }

    if (IN(3)) {
        pg8::GroupSched S{(const char*)A3, (const char*)W_S5W3, G, bx, (size_t)NBC * A3_LD * 2, (size_t)256 * A3_LD * 2, (size_t)256 * A3_LD * 2, 6};
        pg8::EpiS3 E{ACT};
        pg8::gemm_phase<pg8::EpiS3, pg8::GroupSched, false>(lds + RING_OFF, A3_LD * 2, A3_LD * 2, S, E);
        if (BOTH(3)) GRID_BAR();
    }

    if (IN(4)) {
        pg8::DenseSched S{(const char*)ACT, (const char*)W_GLU, NTOK / 256, 2 * D / 256, G, bx, (size_t)256 * D * 2, (size_t)256 * D * 2, D / 64};
        pg8::EpiGLU E{Hb};
        pg8::gemm_phase<pg8::EpiGLU, pg8::DenseSched, false>(lds + RING_OFF, D * 2, D * 2, S, E);
        if (BOTH(4)) GRID_BAR();
    }
#define LN_ROW_STATS(v, mean, rstd) do { float s_ = 0.f; _Pragma("unroll") for (int j = 0; j < 4; ++j) s_ += (v[j][0] + v[j][1]) + (v[j][2] + v[j][3]); mean = wave_sum(s_) * (1.f / D); float s2_ = 0.f; \
        _Pragma("unroll") for (int j = 0; j < 4; ++j) { v[j] = v[j] - mean; s2_ += (v[j][0] * v[j][0] + v[j][1] * v[j][1]) + (v[j][2] * v[j][2] + v[j][3] * v[j][3]); } rstd = 1.f / sqrtf(wave_sum(s2_) * (1.f / D) + LN_EPS); } while (0)
#define LN_LOAD_F32RES(v, RES, BR, m) do { const GAS f32x4* xr_ = (const GAS f32x4*)((RES) + (size_t)(m) * D) + lane; const GAS u32x2* br_ = (const GAS u32x2*)((BR) + (size_t)(m) * D) + lane; \
        _Pragma("unroll") for (int j = 0; j < 4; ++j) { const f32x4 xa = __builtin_nontemporal_load(xr_ + 64 * j); const u32x2 ba = br_[64 * j]; \
            v[j][0] = ALPHA * xa[0] + bf_lo(ba.x); v[j][1] = ALPHA * xa[1] + bf_hi(ba.x); v[j][2] = ALPHA * xa[2] + bf_lo(ba.y); v[j][3] = ALPHA * xa[3] + bf_hi(ba.y); } } while (0)
#define LN_LOAD_BF16RES(v, RES, BR, m) do { const GAS u32x2* xr_ = (const GAS u32x2*)((RES) + (size_t)(m) * D) + lane; const GAS u32x2* br_ = (const GAS u32x2*)((BR) + (size_t)(m) * D) + lane; \
        _Pragma("unroll") for (int j = 0; j < 4; ++j) { const u32x2 xa = xr_[64 * j]; const u32x2 ba = br_[64 * j]; \
            v[j][0] = ALPHA * bf_lo(xa.x) + bf_lo(ba.x); v[j][1] = ALPHA * bf_hi(xa.x) + bf_hi(ba.x); v[j][2] = ALPHA * bf_lo(xa.y) + bf_lo(ba.y); v[j][3] = ALPHA * bf_hi(xa.y) + bf_hi(ba.y); } } while (0)
#define LN_STORE_BF16(v, rstd, DST, m) do { GAS u32x2* o8 = (GAS u32x2*)((DST) + (size_t)(m) * D) + lane; \
        _Pragma("unroll") for (int j = 0; j < 4; ++j) { const f32x4 y = v[j] * rstd * gv[j] + bv[j]; u32x2 w; w.x = cvt_pk_bf16(y[0], y[1]); w.y = cvt_pk_bf16(y[2], y[3]); o8[64 * j] = w; } } while (0)
#define LN_PHASE(LOADER, RES, BR, DST, LIDX) do { const float* gp = args.in[I_LNG] + (LIDX) * D + lane * 4; const float* bp = args.in[I_LNB] + (LIDX) * D + lane * 4; f32x4 gv[4], bv[4]; \
        _Pragma("unroll") for (int j = 0; j < 4; ++j) { gv[j] = *(const GAS f32x4*)(gp + 256 * j); bv[j] = *(const GAS f32x4*)(bp + 256 * j); } \
        for (int m = gw; m < NTOK; m += 2 * NGW) { const int m2 = m + NGW; const bool two = m2 < NTOK; f32x4 va[4], vb[4]; LOADER(va, RES, BR, m); LOADER(vb, RES, BR, (two ? m2 : m)); \
            float mean_a, rstd_a, mean_b, rstd_b; LN_ROW_STATS(va, mean_a, rstd_a); LN_ROW_STATS(vb, mean_b, rstd_b); \
            LN_STORE_BF16(va, rstd_a, DST, m); if (two) LN_STORE_BF16(vb, rstd_b, DST, m2); } } while (0)
    if (IN(5)) { PHASE_IDS(); LN_PHASE(LN_LOAD_F32RES, x_in, Hb, X1, 0); if (BOTH(5)) GRID_BAR(); }

    if (IN(6)) {
        pg8::DenseSched S{(const char*)X1, (const char*)W_FFNIN, NTOK / 256, 2 * FFN / 256, G, bx, (size_t)256 * D * 2, (size_t)256 * D * 2, D / 64};
#if FFN_DOWN_FP8
        pg8::EpiSwiGLU8 E{(fp8*)FFNH, FFN, 1.0f};
        pg8::gemm_phase<pg8::EpiSwiGLU8, pg8::DenseSched, false>(lds + RING_OFF, D * 2, D * 2, S, E);
#else
        pg8::EpiSwiGLU E{FFNH, FFN};
        pg8::gemm_phase<pg8::EpiSwiGLU, pg8::DenseSched, false>(lds + RING_OFF, D * 2, D * 2, S, E);
#endif
        if (BOTH(6)) GRID_BAR();
    }
    if (IN(7)) {
#if FFN_DOWN_FP8
        pg8::DenseSched S{(const char*)FFNH, (const char*)W_FFNOUT, NTOK / 256, D / 256, G, bx, (size_t)256 * FFN, (size_t)256 * FFN, FFN / 128};
        pg8::EpiBf16S E{Hb, D, 1.0f / MOE_SC_OUT};
        pg8::gemm_phase<pg8::EpiBf16S, pg8::DenseSched, false, true>(lds + RING_OFF, FFN, FFN, S, E);
#else
        pg8::DenseSched S{(const char*)FFNH, (const char*)W_FFNOUT, NTOK / 256, D / 256, G, bx, (size_t)256 * FFN * 2, (size_t)256 * FFN * 2, FFN / 64};
        pg8::EpiBf16 E{Hb, D};
        pg8::gemm_phase<pg8::EpiBf16, pg8::DenseSched, false>(lds + RING_OFF, FFN * 2, FFN * 2, S, E);
#endif
        if (BOTH(7)) GRID_BAR();
    }
    if (IN(8)) { PHASE_IDS(); LN_PHASE(LN_LOAD_BF16RES, X1, Hb, X2, 1); if (BOTH(8)) GRID_BAR(); }

    if (IN(9)) {
        pg8::DenseSched S{(const char*)X2, (const char*)W_QKVA, NTOK / 256, QKVA_N / 256, G, bx, (size_t)256 * D * 2, (size_t)256 * D * 2, D / 64};
        if (G == (NTOK / 256) * (QKVA_N / 256)) {
            pg8::EpiQkvaPrep E{CQKV, KROPE, args.in[I_QNORM], args.in[I_KVNORM], ROPE_C, ROPE_S};
            pg8::gemm_phase<pg8::EpiQkvaPrep, pg8::DenseSched, false>(lds + RING_OFF, D * 2, D * 2, S, E);
        } else {
        pg8::EpiF32 E{QKVAF, QKVA_N};
        pg8::gemm_phase<pg8::EpiF32, pg8::DenseSched, false>(lds + RING_OFF, D * 2, D * 2, S, E);
        }
        if (BOTH(9)) GRID_BAR();
    }
    if (IN(10) && G != (NTOK / 256) * (QKVA_N / 256)) {
        PHASE_IDS();
        f32x4 g0 = {0.f, 0.f, 0.f, 0.f}, g1 = {0.f, 0.f, 0.f, 0.f};
        if (lane < 32) { g0 = *(const GAS f32x4*)(args.in[I_QNORM] + lane * 8); g1 = *(const GAS f32x4*)(args.in[I_QNORM] + lane * 8 + 4); }
        else if (lane < 48) { g0 = *(const GAS f32x4*)(args.in[I_KVNORM] + (lane - 32) * 8); g1 = *(const GAS f32x4*)(args.in[I_KVNORM] + (lane - 32) * 8 + 4); }
        for (int m = gw; m < NTOK; m += NGW) {
            const float* rp = QKVAF + (size_t)m * QKVA_N + lane * 8; const f32x4 a0 = *(const GAS f32x4*)(rp), a1 = *(const GAS f32x4*)(rp + 4);
            const float ss = (a0[0] * a0[0] + a0[1] * a0[1]) + (a0[2] * a0[2] + a0[3] * a0[3]) + (a1[0] * a1[0] + a1[1] * a1[1]) + (a1[2] * a1[2] + a1[3] * a1[3]);
            const float sq = wave_sum(lane < 32 ? ss : 0.f), skv = wave_sum((lane >= 32 && lane < 48) ? ss : 0.f);
            const float rq = 1.f / sqrtf(sq * (1.f / QL) + RMS_EPS), rkv = 1.f / sqrtf(skv * (1.f / KVL) + RMS_EPS);
            const int partner = (lane >= 48 && lane < 52) ? lane + 4 : ((lane >= 52 && lane < 56) ? lane - 4 : lane);
            f32x4 p0, p1;
#pragma unroll
            for (int e = 0; e < 4; ++e) { p0[e] = __shfl(a0[e], partner); p1[e] = __shfl(a1[e], partner); }
            if (lane < 48) { const float rs = lane < 32 ? rq : rkv; u32x4 w; w.x = cvt_pk_bf16(a0[0] * rs * g0[0], a0[1] * rs * g0[1]); w.y = cvt_pk_bf16(a0[2] * rs * g0[2], a0[3] * rs * g0[3]);
                w.z = cvt_pk_bf16(a1[0] * rs * g1[0], a1[1] * rs * g1[1]); w.w = cvt_pk_bf16(a1[2] * rs * g1[2], a1[3] * rs * g1[3]); *(GAS u32x4*)(CQKV + (size_t)m * QKVB_K + lane * 8) = w; }
            else if (lane < 56) { const int pos = m & (SEQ - 1), fi = ((lane - 48) & 3) * 8; const float* cp = ROPE_C + pos * 32 + fi; const float* sp = ROPE_S + pos * 32 + fi;
                const f32x4 c0 = *(const GAS f32x4*)(cp), c1 = *(const GAS f32x4*)(cp + 4), s0 = *(const GAS f32x4*)(sp), s1 = *(const GAS f32x4*)(sp + 4); f32x4 o0, o1;
                if (lane < 52) { o0 = a0 * c0 - p0 * s0; o1 = a1 * c1 - p1 * s1; }
                else { o0 = p0 * s0 + a0 * c0; o1 = p1 * s1 + a1 * c1; }
                u32x4 w; w.x = cvt_pk_bf16(o0[0], o0[1]); w.y = cvt_pk_bf16(o0[2], o0[3]); w.z = cvt_pk_bf16(o1[0], o1[1]); w.w = cvt_pk_bf16(o1[2], o1[3]);
                *(GAS u32x4*)(KROPE + (size_t)m * 64 + (lane - 48) * 8) = w; }
        }
        if (BOTH(10)) GRID_BAR();
    }
    if (IN(11)) {
#if MLA_ABSORB
        pg8::DenseSched S{(const char*)CQKV, (const char*)W_QKVB, NTOK / 256, QW / 256, G, bx, (size_t)256 * QKVB_K * 2, (size_t)256 * QL * 2, QL / 64};
        pg8::EpiBf16 E{QKV, QW};
        pg8::gemm_phase<pg8::EpiBf16, pg8::DenseSched, false>(lds + RING_OFF, QL * 2, QKVB_K * 2, S, E);
#else
        pg8::QkvbSched S{(const char*)CQKV, (const char*)W_QKVB, G, bx};
        pg8::EpiBf16 E{QKV, QKVB_N};
        pg8::gemm_phase<pg8::EpiBf16, pg8::QkvbSched, false>(lds + RING_OFF, QKVB_K * 2, QKVB_K * 2, S, E);
#endif
        if (BOTH(11)) GRID_BAR();
    }
    if (IN(12)) {
        att::Conv cv{args.in[I_MOEIN], (unsigned char*)W_MOEIN, 0, G, bx, 0, 0};
        for (int it = vcu; it < BATCH * HEADS * 4; it += G) {
            const int bh = it >> 2, xq = it & 3, b = bh >> 3, h = bh & 7;
            for (int pass = 0; pass < 2; ++pass) { const int qb = pass ? 7 - xq : xq; const size_t tok0 = (size_t)b * SEQ;
#if MLA_ABSORB
                att::attn_block<QW, QKVB_K>(QKV + (tok0 + qb * 256) * QW + h * (QKN + QKR), CQKV + tok0 * QKVB_K + QL, CQKV + tok0 * QKVB_K + QL,
                                KROPE + tok0 * 64, OB + (tok0 + qb * 256) * D + h * VD, qb * 256, ROPE_C, ROPE_S, (char*)lds_raw + RING_OFF, lds + RING_OFF, cv); }
#else
                att::attn_block<QKVB_N, QKVB_N>(QKV + (tok0 + qb * 256) * QKVB_N + h * (QKN + QKR), QKV + tok0 * QKVB_N + QW + h * (QKN + VD), QKV + tok0 * QKVB_N + QW + h * (QKN + VD) + QKN,
                                KROPE + tok0 * 64, OB + (tok0 + qb * 256) * D + h * VD, qb * 256, ROPE_C, ROPE_S, (char*)lds_raw + RING_OFF, lds + RING_OFF, cv); }
#endif
        }
        if (CONV_IN_ATTN) att::conv_drain(cv, lds + RING_OFF);
        __syncthreads();
        if (BOTH(12)) GRID_BAR();
    }
    if (IN(13)) {
        pg8::DenseSched S{(const char*)OB, (const char*)W_OW, NTOK / 256, D / 256, G, bx, (size_t)256 * D * 2, (size_t)256 * D * 2, D / 64};
        pg8::EpiBf16 E{H3b, D};
        pg8::gemm_phase<pg8::EpiBf16, pg8::DenseSched, false>(lds + RING_OFF, D * 2, D * 2, S, E);
        if (BOTH(13)) GRID_BAR();
    }
    if (IN(14)) {
        PHASE_IDS();
        LAS int* L_E = (LAS int*)(lds + RING_OFF);
        LAS int* L_CNT = L_E + 128;
        LAS int* L_BASE = L_CNT + 8;
        LAS int* L_RANK = L_BASE + 8;
        const float* gp = args.in[I_LNG] + 2 * D + lane * 4; const float* bp = args.in[I_LNB] + 2 * D + lane * 4; f32x4 gv[4], bv[4];
#pragma unroll
        for (int j = 0; j < 4; ++j) { gv[j] = *(const GAS f32x4*)(gp + 256 * j); bv[j] = *(const GAS f32x4*)(bp + 256 * j); }
        f32x4 rw[16][2];
#pragma unroll
        for (int j = 0; j < 4; ++j)
#pragma unroll
            for (int q = 0; q < 4; ++q) { const float* wk = args.in[I_ROUTER] + (size_t)(j * 256 + lane * 4 + q) * 8; rw[j * 4 + q][0] = *(const GAS f32x4*)(wk); rw[j * 4 + q][1] = *(const GAS f32x4*)(wk + 4); }
        for (int rb = bx; rb < NTOK / 128; rb += G) {
            if (tid < 8) L_CNT[tid] = 0;
            __syncthreads();
            for (int i = 0; i < 16; ++i) {
                const int m = rb * 128 + wave * 16 + i;
                f32x4 v[4]; LN_LOAD_BF16RES(v, X2, H3b, m);
                float mean, rstd; LN_ROW_STATS(v, mean, rstd);
                float lg[8];
#pragma unroll
                for (int e = 0; e < 8; ++e) lg[e] = 0.f;
                GAS u32x2* o8 = (GAS u32x2*)(X3 + (size_t)m * D) + lane;
#pragma unroll
                for (int j = 0; j < 4; ++j) { const f32x4 y = v[j] * rstd * gv[j] + bv[j]; u32x2 w; w.x = cvt_pk_bf16(y[0], y[1]); w.y = cvt_pk_bf16(y[2], y[3]); o8[64 * j] = w;
#if MOE_FP8
                    *((GAS unsigned*)(X3Q + (size_t)m * D) + 64 * j + lane) = pk4_fp8(y[0], y[1], y[2], y[3]);
#endif
#pragma unroll
                    for (int q = 0; q < 4; ++q) { const f32x4 w0 = rw[j * 4 + q][0], w1 = rw[j * 4 + q][1];
                        lg[0] += y[q] * w0[0]; lg[1] += y[q] * w0[1]; lg[2] += y[q] * w0[2]; lg[3] += y[q] * w0[3]; lg[4] += y[q] * w1[0]; lg[5] += y[q] * w1[1]; lg[6] += y[q] * w1[2]; lg[7] += y[q] * w1[3]; } }
#pragma unroll
                for (int e = 0; e < 8; ++e) lg[e] = wave_sum(lg[e]);
                int e0 = 0; float v0 = lg[0];
#pragma unroll
                for (int e = 1; e < 8; ++e) if (lg[e] > v0) { v0 = lg[e]; e0 = e; }
                int e1 = (e0 == 0) ? 1 : 0; float v1 = (e0 == 0) ? lg[1] : lg[0];
#pragma unroll
                for (int e = 1; e < 8; ++e) if (e != e0 && lg[e] > v1) { v1 = lg[e]; e1 = e; }
                const float ex = __expf(v1 - v0), g0 = 1.f / (1.f + ex), g1 = ex / (1.f + ex);
                if (lane == 0) { L_E[wave * 16 + i] = e0 | (e1 << 8); GATES[(size_t)m * 2] = g0; GATES[(size_t)m * 2 + 1] = g1; }
            }
            __syncthreads();
            if (tid < 128) { const int ee = L_E[tid]; L_RANK[2 * tid] = __hip_atomic_fetch_add(&L_CNT[ee & 255], 1, __ATOMIC_RELAXED, __HIP_MEMORY_SCOPE_WORKGROUP); L_RANK[2 * tid + 1] = __hip_atomic_fetch_add(&L_CNT[ee >> 8], 1, __ATOMIC_RELAXED, __HIP_MEMORY_SCOPE_WORKGROUP); }
            __syncthreads();
            if (tid < 8) L_BASE[tid] = (int)__hip_atomic_fetch_add((unsigned*)(ctl + CW_ECNT + 64 * tid), (unsigned)L_CNT[tid], RLX_AGENT);
            __syncthreads();
            if (tid < 128) { const int ee = L_E[tid], e0 = ee & 255, e1 = ee >> 8, m = rb * 128 + tid; const int p0 = L_BASE[e0] + L_RANK[2 * tid], p1 = L_BASE[e1] + L_RANK[2 * tid + 1];
                ROW_TOK[e0 * NTOK + p0] = m; ROW_TOK[e1 * NTOK + p1] = m; *(GAS i32x4*)(TOK_INFO + (size_t)m * 4) = (i32x4){e0, p0, e1, p1}; }
            __syncthreads();
        }
        if (BOTH(14)) GRID_BAR();
    }
    if (IN(15)) {
#if MOE_FP8
        pg8::MoeSched S; S.A = (const char*)X3Q; S.Bt = (const char*)W_MOEIN; S.row_tok = ROW_TOK; S.nN = 2 * EXD / 256; S.nt = D / 128; S.G = G; S.c = bx; S.astep = 0; S.bexp = (size_t)2 * EXD * D; S.bstep = (size_t)256 * D; S.rowb = D;
        S.init((const unsigned*)(ctl + CW_ECNT));
        pg8::EpiSwiGLU8 E{(fp8*)MOEH, EXD, 1.0f / MOE_SC_IN};
        pg8::gemm_phase<pg8::EpiSwiGLU8, pg8::MoeSched, true, true>(lds + RING_OFF, D, D, S, E);
#else
        pg8::MoeSched S; S.A = (const char*)X3; S.Bt = (const char*)W_MOEIN; S.row_tok = ROW_TOK; S.nN = 2 * EXD / 256; S.nt = D / 64; S.G = G; S.c = bx; S.astep = 0; S.bexp = (size_t)2 * EXD * D * 2; S.bstep = (size_t)256 * D * 2; S.rowb = D * 2;
        S.init((const unsigned*)(ctl + CW_ECNT));
        pg8::EpiSwiGLU E{MOEH, EXD};
        pg8::gemm_phase<pg8::EpiSwiGLU, pg8::MoeSched, true>(lds + RING_OFF, D * 2, D * 2, S, E);
#endif
        if (BOTH(15)) GRID_BAR();
    }
    if (IN(16)) {
#if MOE_FP8
        pg8::MoeDownSched S; S.A = (const char*)MOEH; S.Bt = (const char*)W_MOEOUT; S.row_tok = ROW_TOK; S.nN = D / 256; S.nt = EXD / 128; S.G = G; S.c = bx; S.astep = (size_t)256 * EXD; S.bexp = (size_t)D * EXD; S.bstep = (size_t)256 * EXD; S.rowb = 0;
        S.init((const unsigned*)(ctl + CW_ECNT)); S.init2();
        pg8::EpiMoeDown E{YB, YSLAB, S.T0, (S.ts[NEXP] - S.T0) * 256, 1.0f / MOE_SC_OUT};
        pg8::gemm_phase<pg8::EpiMoeDown, pg8::MoeDownSched, false, true>(lds + RING_OFF, EXD, EXD, S, E);
#else
        pg8::MoeSched S; S.A = (const char*)MOEH; S.Bt = (const char*)W_MOEOUT; S.row_tok = ROW_TOK; S.nN = D / 256; S.nt = EXD / 64; S.G = G; S.c = bx; S.astep = (size_t)256 * EXD * 2; S.bexp = (size_t)D * EXD * 2; S.bstep = (size_t)256 * EXD * 2; S.rowb = 0;
        S.init((const unsigned*)(ctl + CW_ECNT));
        pg8::EpiBf16 E{YB, D};
        pg8::gemm_phase<pg8::EpiBf16, pg8::MoeSched, false>(lds + RING_OFF, EXD * 2, EXD * 2, S, E);
#endif
        if (BOTH(16)) GRID_BAR();
    }
    if (IN(17)) {
        PHASE_IDS();
        int ts[NEXP]; { int t = 0;
#pragma unroll
            for (int e = 0; e < NEXP; ++e) { const int c = (int)__builtin_amdgcn_readfirstlane(__hip_atomic_load((const unsigned*)(ctl + CW_ECNT + 64 * e), __ATOMIC_RELAXED, __HIP_MEMORY_SCOPE_AGENT)); ts[e] = t; t += (c + 255) >> 8; } }
        const float* gp = args.in[I_LNG] + 3 * D + lane * 4; const float* bp = args.in[I_LNB] + 3 * D + lane * 4; f32x4 gv[4], bv[4];
#pragma unroll
        for (int j = 0; j < 4; ++j) { gv[j] = *(const GAS f32x4*)(gp + 256 * j); bv[j] = *(const GAS f32x4*)(bp + 256 * j); }
        int T0_ = 0, tailr_ = 0;
#if MOE_FP8
        { int tt = 0;
#pragma unroll
          for (int e = 0; e < NEXP; ++e) { const int c = (int)__builtin_amdgcn_readfirstlane(__hip_atomic_load((const unsigned*)(ctl + CW_ECNT + 64 * e), __ATOMIC_RELAXED, __HIP_MEMORY_SCOPE_AGENT)); tt += (c + 255) >> 8; }
          const int per = (G % 4 == 0) ? G / 4 : 1; T0_ = (tt / per) * per; tailr_ = (tt - T0_) * 256; }
#else
        T0_ = 1 << 30;
#endif
#define P17_YROW(yv, r_) do { const int r__ = (r_); if ((r__ >> 8) < T0_) { const GAS u32x2* yp = (const GAS u32x2*)(YB + (size_t)r__ * D) + lane; \
                _Pragma("unroll") for (int j = 0; j < 4; ++j) { const u32x2 ya = yp[64 * j]; yv[j] = (f32x4){bf_lo(ya.x), bf_hi(ya.x), bf_lo(ya.y), bf_hi(ya.y)}; } } \
            else { const GAS f32x4* sp_ = (const GAS f32x4*)(YSLAB + (size_t)(r__ - T0_ * 256) * D) + lane; _Pragma("unroll") for (int j = 0; j < 4; ++j) yv[j] = sp_[64 * j]; \
                for (int ks = 1; ks < pg8::MOE_KS; ++ks) { const GAS f32x4* sq_ = sp_ + (size_t)ks * tailr_ * (D / 4); _Pragma("unroll") for (int j = 0; j < 4; ++j) yv[j] += sq_[64 * j]; } } } while (0)
#define P17_LOAD(v, m_) do { const i32x4 ti = *(const GAS i32x4*)(TOK_INFO + (size_t)(m_) * 4); const float g0 = GATES[(size_t)(m_) * 2], g1 = GATES[(size_t)(m_) * 2 + 1]; int t0 = 0, t1 = 0; \
            _Pragma("unroll") for (int e = 0; e < NEXP; ++e) { t0 = (ti.x == e) ? ts[e] : t0; t1 = (ti.z == e) ? ts[e] : t1; } \
            const int r0_ = t0 * 256 + ti.y, r1_ = t1 * 256 + ti.w; const GAS u32x2* xr = (const GAS u32x2*)(X3 + (size_t)(m_) * D) + lane; \
            if ((r0_ >> 8) < T0_ && (r1_ >> 8) < T0_) {     \
                const GAS u32x2* y0 = (const GAS u32x2*)(YB + (size_t)r0_ * D) + lane; const GAS u32x2* y1 = (const GAS u32x2*)(YB + (size_t)r1_ * D) + lane; \
                _Pragma("unroll") for (int j = 0; j < 4; ++j) { const u32x2 xa = __builtin_nontemporal_load(xr + 64 * j), ya = __builtin_nontemporal_load(y0 + 64 * j), yb = __builtin_nontemporal_load(y1 + 64 * j); \
                    v[j][0] = ALPHA * bf_lo(xa.x) + (g0 * bf_lo(ya.x) + g1 * bf_lo(yb.x)); v[j][1] = ALPHA * bf_hi(xa.x) + (g0 * bf_hi(ya.x) + g1 * bf_hi(yb.x)); \
                    v[j][2] = ALPHA * bf_lo(xa.y) + (g0 * bf_lo(ya.y) + g1 * bf_lo(yb.y)); v[j][3] = ALPHA * bf_hi(xa.y) + (g0 * bf_hi(ya.y) + g1 * bf_hi(yb.y)); } } \
            else { f32x4 ya_[4], yb_[4]; P17_YROW(ya_, r0_); P17_YROW(yb_, r1_); \
                _Pragma("unroll") for (int j = 0; j < 4; ++j) { const u32x2 xa = xr[64 * j]; \
                    v[j][0] = ALPHA * bf_lo(xa.x) + (g0 * ya_[j][0] + g1 * yb_[j][0]); v[j][1] = ALPHA * bf_hi(xa.x) + (g0 * ya_[j][1] + g1 * yb_[j][1]); \
                    v[j][2] = ALPHA * bf_lo(xa.y) + (g0 * ya_[j][2] + g1 * yb_[j][2]); v[j][3] = ALPHA * bf_hi(xa.y) + (g0 * ya_[j][3] + g1 * yb_[j][3]); } } } while (0)
#define P17_STORE(v, rstd, m_) do { GAS f32x4* o = (GAS f32x4*)(args.out + (size_t)(m_) * D) + lane; _Pragma("unroll") for (int j = 0; j < 4; ++j) __builtin_nontemporal_store(v[j] * rstd * gv[j] + bv[j], o + 64 * j); } while (0)
        for (int m = gw; m < NTOK; m += 2 * NGW) { const int m2 = m + NGW; const bool two = m2 < NTOK;
            f32x4 va[4], vb[4]; P17_LOAD(va, m); P17_LOAD(vb, (two ? m2 : m));
            float mean_a, rstd_a, mean_b, rstd_b; LN_ROW_STATS(va, mean_a, rstd_a); LN_ROW_STATS(vb, mean_b, rstd_b);
            P17_STORE(va, rstd_a, m); if (two) P17_STORE(vb, rstd_b, m2);
        }
    }
#undef IN
#undef BOTH
}

extern "C" void kernel_launch(void* const* d_in, const int* in_sizes, int n_in, void* d_out, int out_size, void* d_ws, size_t ws_size, hipStream_t stream) {
    static int grid = 0;
    if (grid == 0) {
        if (n_in != 24 || in_sizes[0] != NTOK * D || out_size != NTOK * D || ws_size < WS_END) { fprintf(stderr, "kernel_launch: unexpected shapes (n_in %d, in0 %d, out %d, ws %zu < %zu); nothing launched\n", n_in, n_in > 0 ? in_sizes[0] : -1, out_size, ws_size, (size_t)WS_END); grid = -1; return; }
        int dev = 0, cus = 0, per_cu = 0;
        if (hipGetDevice(&dev) != hipSuccess || hipDeviceGetAttribute(&cus, hipDeviceAttributeMultiprocessorCount, dev) != hipSuccess) { grid = -1; return; }
        if (hipFuncSetAttribute((const void*)yoco_fwd, hipFuncAttributeMaxDynamicSharedMemorySize, LDS_BYTES) != hipSuccess) { fprintf(stderr, "kernel_launch: hipFuncSetAttribute failed\n"); grid = -1; return; }
        if (hipOccupancyMaxActiveBlocksPerMultiprocessor(&per_cu, (const void*)yoco_fwd, NWAVES * 64, LDS_BYTES) != hipSuccess || per_cu < 1) { fprintf(stderr, "kernel_launch: occupancy query reports %d blocks per CU\n", per_cu); }
        (void)hipGetLastError();
        grid = cus;
    }
    if (grid < 0) return;
    if (hipMemsetAsync((char*)d_ws + WS_CTL, 0, CTL_ZERO_BYTES, stream) != hipSuccess) return;
    Args a{};
    for (int i = 0; i < 24; ++i) a.in[i] = (const float*)d_in[i];
    a.out = (float*)d_out; a.ws = (unsigned char*)d_ws;
    constexpr int NPH = 18;
    if (MK_N_LAUNCHES == 1) { a.ph_lo = 0; a.ph_hi = NPH; a.li = 0; hipLaunchKernelGGL(yoco_fwd, dim3(grid), dim3(NWAVES * 64), LDS_BYTES, stream, a); }
    else { for (int p = 0; p < NPH; ++p) { a.ph_lo = p; a.ph_hi = p + 1; a.li = p; hipLaunchKernelGGL(yoco_fwd, dim3(grid), dim3(NWAVES * 64), LDS_BYTES, stream, a); } }
#ifdef PROBE_MASK
    for (int p = 0; p < NPH + 8; ++p) if ((PROBE_MASK >> p) & 1) { a.ph_lo = p; a.ph_hi = p + 1; a.li = 1; hipLaunchKernelGGL(yoco_fwd, dim3(grid), dim3(NWAVES * 64), LDS_BYTES, stream, a); }
#endif
}
```

```cpp
#include <hip/hip_runtime.h>
#include <cstdio>
#include <cstdint>

#ifndef MOE_FP8
#define MOE_FP8 1
#endif
#ifndef FFN_DOWN_FP8
#define FFN_DOWN_FP8 1
#endif
#ifndef PG8_ALIGN_EPI
#define PG8_ALIGN_EPI 1
#endif
#ifndef MLA_ABSORB
#define CONV_IN_ATTN 1
#define MLA_ABSORB 1
#endif
#ifndef MK_N_LAUNCHES
#define MK_N_LAUNCHES 1
#endif

#define GAS __attribute__((address_space(1)))
#define LAS __attribute__((address_space(3)))
typedef unsigned short bf16;
typedef short bf16x8 __attribute__((ext_vector_type(8)));
typedef short s16x4 __attribute__((ext_vector_type(4)));
typedef float f32x2 __attribute__((ext_vector_type(2)));
typedef float f32x4 __attribute__((ext_vector_type(4)));
typedef float f32x16 __attribute__((ext_vector_type(16)));
typedef unsigned u32x2 __attribute__((ext_vector_type(2)));
typedef unsigned u32x4 __attribute__((ext_vector_type(4)));
typedef int i32x4 __attribute__((ext_vector_type(4)));
typedef int i32x8 __attribute__((ext_vector_type(8)));
typedef unsigned char fp8;

constexpr int D = 1024, BATCH = 16, SEQ = 2048, NTOK = BATCH * SEQ;
constexpr int S5G = 64, S5C = 16, S5P = 64;
constexpr int LCH = 16, NCHUNK = SEQ / LCH, NBC = BATCH * NCHUNK;
constexpr int A3_LD = 384;
constexpr int HEADS = 8, QKN = 128, QKR = 64, VD = 128, QL = 256, KVL = 128;
constexpr int QKVA_N = 512, QKVB_N = 3584, QKVB_K = 384, QW = HEADS * (QKN + QKR);
constexpr int FFN = 2816, NEXP = 8, EXD = 3584;
constexpr float ALPHA = 1.41421356237f, LN_EPS = 1e-5f, RMS_EPS = 1e-6f;
constexpr float MOE_SC_IN = 32.0f, MOE_SC_OUT = 128.0f;
constexpr int MOE_ROWS = 2 * NTOK + NEXP * 256;

constexpr size_t MiB = 1u << 20;
constexpr size_t WS_CTL = 0, CTL_ZERO_BYTES = 128 * 1024;
constexpr size_t WS_MOEIN = 1 * MiB;
constexpr size_t WS_MOEOUT = WS_MOEIN + 112 * MiB;
constexpr size_t WS_FFNIN = WS_MOEOUT + 56 * MiB;
constexpr size_t WS_FFNOUT = WS_FFNIN + 11 * MiB;
constexpr size_t WS_GLU = WS_FFNOUT + 6 * MiB;
constexpr size_t WS_OW = WS_GLU + 4 * MiB;
constexpr size_t WS_QKVB = WS_OW + 2 * MiB;
constexpr size_t WS_QKVA = WS_QKVB + 3 * MiB;
constexpr size_t WS_S5ST = WS_QKVA + 1 * MiB;
constexpr size_t WS_S5W3 = WS_S5ST + 8 * MiB;
constexpr size_t WS_ROPE = WS_S5W3 + 12 * MiB;
constexpr size_t WS_PTAB = WS_ROPE + 1 * MiB;
constexpr size_t WS_BBTAB = WS_PTAB + 1 * MiB;
constexpr size_t WS_ACTS = WS_BBTAB + 1 * MiB;
constexpr size_t WS_A3 = WS_ACTS;
constexpr size_t WS_SEND = WS_A3 + 96 * MiB;
constexpr size_t WS_ACT = WS_SEND + 64 * MiB;
constexpr size_t WS_H = WS_ACT + 64 * MiB;
constexpr size_t WS_X1 = WS_H + 128 * MiB;
constexpr size_t WS_FFNH = WS_X1 + 64 * MiB;
constexpr size_t WS_X2 = WS_ACTS;
constexpr size_t WS_QKVAF = WS_X2 + 64 * MiB;
constexpr size_t WS_CQKV = WS_QKVAF + 64 * MiB;
constexpr size_t WS_KROPE = WS_CQKV + 24 * MiB;
constexpr size_t WS_QKV = WS_KROPE + 4 * MiB;
constexpr size_t WS_H3 = WS_QKV + 224 * MiB;
constexpr size_t WS_O = WS_H3 + 128 * MiB;
constexpr size_t WS_X3 = WS_ACTS;
constexpr size_t WS_MOEH = WS_X3 + 64 * MiB;
constexpr size_t WS_Y = WS_MOEH + 462 * MiB;
constexpr size_t WS_ROUTE = WS_Y + 132 * MiB;
constexpr size_t WS_END = WS_ROUTE + 2 * MiB;
static_assert(WS_FFNH + 176 * MiB <= WS_END && WS_O + 64 * MiB <= WS_END, "d_ws map");
static_assert(WS_END <= 896 * MiB, "d_ws map exceeds 4x the largest input");
static_assert(WS_H3 >= WS_QKV + (size_t)NTOK * QKVB_N * 2, "d_ws map");

constexpr int CW_BAR = 4096;
constexpr int CW_ECNT = 16384;

constexpr int RING_OFF = 0, RING_BYTES = 131072;
constexpr int IDX_OFF = 131072;
constexpr int LDSCTL_OFF = 139264, MISC_OFF = LDSCTL_OFF + 320;
constexpr int LDS_BYTES = 147456;
constexpr int NWAVES = 8;

#define RLX_AGENT __ATOMIC_RELAXED, __HIP_MEMORY_SCOPE_AGENT
#define LDS_WAIT() asm volatile("s_waitcnt lgkmcnt(0)" ::: "memory")
#define VM_WAIT() asm volatile("s_waitcnt vmcnt(0)" ::: "memory")

__device__ __forceinline__ unsigned cvt_pk_bf16(float lo, float hi) { unsigned r; asm volatile("v_cvt_pk_bf16_f32 %0, %1, %2" : "=v"(r) : "v"(lo), "v"(hi)); return r; }
__device__ __forceinline__ unsigned pk4_fp8(float a, float b, float c, float d) { int r = 0; r = __builtin_amdgcn_cvt_pk_fp8_f32(a, b, r, false); r = __builtin_amdgcn_cvt_pk_fp8_f32(c, d, r, true); return (unsigned)r; }
__device__ __forceinline__ float bf_lo(unsigned w) { return __uint_as_float(w << 16); }
__device__ __forceinline__ float bf_hi(unsigned w) { return __uint_as_float(w & 0xffff0000u); }
template <int CTRL> __device__ __forceinline__ float dpp_mov(float v) { return __builtin_bit_cast(float, __builtin_amdgcn_update_dpp(0, __builtin_bit_cast(int, v), CTRL, 0xf, 0xf, true)); }
__device__ __forceinline__ float wave_sum(float v) {
    v += dpp_mov<0xB1>(v);
    v += dpp_mov<0x4E>(v);
    v += dpp_mov<0x141>(v);
    v += dpp_mov<0x140>(v);
    { auto r = __builtin_amdgcn_permlane16_swap(__float_as_uint(v), __float_as_uint(v), false, false); v = __uint_as_float(r[0]) + __uint_as_float(r[1]); }
    { auto r = __builtin_amdgcn_permlane32_swap(__float_as_uint(v), __float_as_uint(v), false, false); v = __uint_as_float(r[0]) + __uint_as_float(r[1]); }
    return v;
}
__device__ __forceinline__ float sigmoid_f(float x) { return __builtin_amdgcn_rcpf(1.0f + __builtin_amdgcn_exp2f(-1.4426950408889634f * x)); }
__device__ __forceinline__ float gelu_tanh_f(float x) { return x * sigmoid_f(1.5957691216057308f * x * (1.0f + 0.044715f * x * x)); }

namespace pg8 {
constexpr int BM = 256, BK = 64, HALF = 128, HTB = HALF * BK * 2, STAGE_BYTES = 8 * HTB, NXCD = 8, WGM = 8;
__host__ __device__ __forceinline__ int lds_byte(int r, int c) { const int st = (r >> 4) * 2 + (c >> 5), rr = r & 15, cc = c & 31, ob = rr * 64 + cc * 2; return st * 1024 + (ob ^ (((ob >> 9) & 1) << 5)); }
__host__ __device__ __forceinline__ void stage_rc(int b, int& R, int& C) { const int st = b / 1024, sb = b % 1024, swz = sb ^ (((sb >> 9) & 1) << 5); R = (st >> 1) * 16 + swz / 64; C = (st & 1) * 32 + (swz % 64) / 2; }
__host__ __device__ __forceinline__ int perm32(int rho) { const int n = rho >> 4, i = rho & 15; return 8 * (i >> 2) + 4 * n + (i & 3); }

struct Unit { int pm, pn, aux, aux2, nt; const char* a; const char* b; };

__device__ __forceinline__ bool tile_of(long L, int nM, int nN, int& pm, int& pn) {
    const int nwg = nM * nN; if (L >= nwg) return false;
    int wgid = (int)L; { const int q = nwg / NXCD, r = nwg % NXCD, xcd = wgid % NXCD, off = wgid / NXCD; wgid = (xcd < r ? xcd * (q + 1) : r * (q + 1) + (xcd - r) * q) + off; }
    const int nig = WGM * nN, gid = wgid / nig, fm = gid * WGM, gsz = (nM - fm) < WGM ? (nM - fm) : WGM;
    pm = fm + ((wgid % nig) % gsz); pn = (wgid % nig) / gsz; return true;
}

template <class E, class = void> struct epi_after_drain { static constexpr bool value = false; };
template <class E> struct epi_after_drain<E, decltype((void)E::AFTER_DRAIN)> { static constexpr bool value = E::AFTER_DRAIN; };
template <bool F8> struct frag_sel;
template <> struct frag_sel<false> { struct A4 { bf16x8 v[4][2]; }; struct B2 { bf16x8 v[2][2]; }; };
template <> struct frag_sel<true>  { struct A4 { i32x8 v[4]; };     struct B2 { i32x8 v[2]; }; };
template <class Epi, class Sched, bool GATHER, bool FP8 = false>
__device__ __forceinline__ void gemm_phase(LAS unsigned char* lds, const int ldb_, const int lda_, const Sched& S, const Epi& E) {
    int K = ldb_, lda = lda_; asm volatile("" : "+s"(K), "+s"(lda));
    int tid_ = threadIdx.x; asm volatile("" : "+v"(tid_));
    const int tid = tid_, wid = __builtin_amdgcn_readfirstlane(tid >> 6), lane = tid & 63, wr = wid >> 2, wc = wid & 3, fr = lane & 15, fq = lane >> 4;
    int R[2], C[2]; unsigned voffB[2], ca[4];
#pragma unroll
    for (int i = 0; i < 2; ++i) { stage_rc(tid * 16 + i * 8192, R[i], C[i]); const int Rb = Epi::PERM ? ((R[i] & ~31) + perm32(R[i] & 31)) : R[i];
        voffB[i] = (unsigned)(Rb * K + C[i] * 2); ca[i] = (unsigned)(R[i] * lda + C[i] * 2); ca[2 + i] = (unsigned)((HALF + R[i]) * lda + C[i] * 2); }
    const size_t kstep = (size_t)(BK * 2);
    const size_t hstepB = (size_t)HALF * K;
    const unsigned ldsw = (unsigned)wid * 1024u;
    const int aoff = lds_byte(wr * 64 + fr, fq * 8), boff = lds_byte(wc * 32 + fr, fq * 8);
#define PG8_SA(b, h) (((b) * 2 + (h)) * HTB)
#define PG8_SB(b, h) ((4 + (b) * 2 + (h)) * HTB)
#define PG8_STAGE(bufoff, gbase, o0, o1) do { \
        __builtin_amdgcn_global_load_lds((const unsigned*)((const char*)(gbase) + (o0)), (LAS unsigned*)(lds + (bufoff) + ldsw), 16, 0, 0); \
        __builtin_amdgcn_global_load_lds((const unsigned*)((const char*)(gbase) + (o1)), (LAS unsigned*)(lds + (bufoff) + ldsw + 8192), 16, 0, 0); } while (0)
#define PG8_STAGEB(bufoff, gbase) PG8_STAGE(bufoff, gbase, voffB[0], voffB[1])
#define PG8_LD16(off) (*(const LAS i32x4*)(lds + (off)))
#define PG8_LDA(dst, b, h) do { _Pragma("unroll") for (int m = 0; m < 4; ++m) { \
        if constexpr (FP8) { const i32x4 lo_ = PG8_LD16(PG8_SA(b, h) + aoff + m * 2048), hi_ = PG8_LD16(PG8_SA(b, h) + aoff + m * 2048 + 1024); dst.v[m] = __builtin_shufflevector(lo_, hi_, 0, 1, 2, 3, 4, 5, 6, 7); } \
        else { _Pragma("unroll") for (int k = 0; k < 2; ++k) dst.v[m][k] = *(const LAS bf16x8*)(lds + PG8_SA(b, h) + aoff + m * 2048 + k * 1024); } } } while (0)
#define PG8_LDB(dst, b, h) do { _Pragma("unroll") for (int n = 0; n < 2; ++n) { \
        if constexpr (FP8) { const i32x4 lo_ = PG8_LD16(PG8_SB(b, h) + boff + n * 2048), hi_ = PG8_LD16(PG8_SB(b, h) + boff + n * 2048 + 1024); dst.v[n] = __builtin_shufflevector(lo_, hi_, 0, 1, 2, 3, 4, 5, 6, 7); } \
        else { _Pragma("unroll") for (int k = 0; k < 2; ++k) dst.v[n][k] = *(const LAS bf16x8*)(lds + PG8_SB(b, h) + boff + n * 2048 + k * 1024); } } } while (0)
#define PG8_MMA(ai, bj, At, Bt) do { __builtin_amdgcn_s_setprio(1); \
        if constexpr (FP8) { _Pragma("unroll") for (int m = 0; m < 4; ++m) _Pragma("unroll") for (int n = 0; n < 2; ++n) \
            asm volatile("v_mfma_f32_16x16x128_f8f6f4 %0, %1, %2, %0" : "+v"(acc[ai][bj][m][n]) : "v"(Bt.v[n]), "v"(At.v[m])); } \
        else { _Pragma("unroll") for (int m = 0; m < 4; ++m) _Pragma("unroll") for (int n = 0; n < 2; ++n) _Pragma("unroll") for (int k = 0; k < 2; ++k) \
            acc[ai][bj][m][n] = __builtin_amdgcn_mfma_f32_16x16x32_bf16(Bt.v[n][k], At.v[m][k], acc[ai][bj][m][n], 0, 0, 0); } \
        __builtin_amdgcn_s_setprio(0); } while (0)
#define PG8_WAIT_V(n) asm volatile("s_waitcnt vmcnt(" #n ")" ::: "memory")
#define PG8_WAIT_L(n) asm volatile("s_waitcnt lgkmcnt(" #n ")" ::: "memory")
#define PG8_BAR __builtin_amdgcn_s_barrier()
#define PG8_SCHED __builtin_amdgcn_sched_barrier(0)
    Unit cur, nxt; int ui = 0;
    if (!S.next(0, cur)) return;
    if constexpr (GATHER) S.gather(cur, R, C, ca);
    f32x4 acc[2][2][4][2];
#pragma unroll
    for (int a = 0; a < 2; ++a)
#pragma unroll
        for (int b = 0; b < 2; ++b)
#pragma unroll
            for (int m = 0; m < 4; ++m)
#pragma unroll
                for (int n = 0; n < 2; ++n) acc[a][b][m][n] = (f32x4){0.f, 0.f, 0.f, 0.f};
    typedef typename frag_sel<FP8>::A4 FragA; typedef typename frag_sel<FP8>::B2 FragB;
    FragA At; FragB B0, B1;
    const char* cA = cur.a; const char* cB = cur.b;
    PG8_STAGEB(PG8_SB(0, 0), cB); PG8_STAGEB(PG8_SB(0, 1), cB + hstepB); PG8_STAGE(PG8_SA(0, 0), cA, ca[0], ca[1]); PG8_STAGE(PG8_SA(0, 1), cA, ca[2], ca[3]);
    if (wr == 1) PG8_BAR;
    PG8_WAIT_V(2); PG8_BAR;
    PG8_STAGEB(PG8_SB(1, 0), cB + kstep); PG8_STAGE(PG8_SA(1, 0), cA + kstep, ca[0], ca[1]); PG8_STAGEB(PG8_SB(1, 1), cB + hstepB + kstep);
    PG8_WAIT_V(6); PG8_BAR;
    for (;;) {
        const bool has_next = S.next(ui + 1, nxt);
        const char* nA = has_next ? nxt.a : cA; const char* nB = has_next ? nxt.b : cB;
        const int nt = cur.nt;
        for (int t = 0; t < nt; t += 2) {
            const bool last = (t == nt - 2);
            const char* a1 = cA + (size_t)(t + 1) * kstep;
            const char* a2 = last ? nA : cA + (size_t)(t + 2) * kstep; const char* b2 = last ? nB : cB + (size_t)(t + 2) * kstep;
            const char* a3 = a2 + kstep; const char* b3 = b2 + kstep;
            PG8_LDB(B0, 0, 0); PG8_LDB(B1, 0, 1); PG8_SCHED; PG8_LDA(At, 0, 0); PG8_STAGE(PG8_SA(1, 1), a1, ca[2], ca[3]);
            PG8_WAIT_V(8); PG8_WAIT_L(0); PG8_BAR; PG8_MMA(0, 0, At, B0); PG8_MMA(0, 1, At, B1); PG8_BAR; PG8_SCHED;
            if constexpr (GATHER) { if (last && has_next) {
                int t2 = tid; asm volatile("" : "+v"(t2)); int R2[2], C2[2]; stage_rc(t2 * 16, R2[0], C2[0]); stage_rc(t2 * 16 + 8192, R2[1], C2[1]);
#pragma unroll
                for (int k = 0; k < 4; ++k) ca[k] = S.off_of(*(const LAS int*)(lds + IDX_OFF + wid * 1024 + k * 256 + lane * 4), C2[k & 1]); } }
            PG8_LDA(At, 0, 1);
            if constexpr (GATHER) { if (t == 0 && has_next) {
                int t2 = tid; asm volatile("" : "+v"(t2)); int R2[2], C2[2]; stage_rc(t2 * 16, R2[0], C2[0]); stage_rc(t2 * 16 + 8192, R2[1], C2[1]);
#pragma unroll
                for (int k = 0; k < 4; ++k) __builtin_amdgcn_global_load_lds((const unsigned*)S.idx_src(nxt, (k >> 1) * HALF + R2[k & 1]), (LAS unsigned*)(lds + IDX_OFF + wid * 1024 + k * 256), 4, 0, 0); } }
            PG8_STAGEB(PG8_SB(0, 0), b2); PG8_STAGEB(PG8_SB(0, 1), b2 + hstepB); PG8_STAGE(PG8_SA(0, 0), a2, ca[0], ca[1]);
            PG8_WAIT_V(8); PG8_WAIT_L(0); PG8_BAR; PG8_MMA(1, 0, At, B0); PG8_MMA(1, 1, At, B1); PG8_BAR; PG8_SCHED;
            PG8_LDB(B0, 1, 0); PG8_LDB(B1, 1, 1); PG8_SCHED; PG8_LDA(At, 1, 0); PG8_STAGE(PG8_SA(0, 1), a2, ca[2], ca[3]);
            PG8_WAIT_V(8); PG8_WAIT_L(0); PG8_BAR; PG8_MMA(0, 0, At, B0); PG8_MMA(0, 1, At, B1); PG8_BAR; PG8_SCHED;
            PG8_LDA(At, 1, 1); PG8_STAGEB(PG8_SB(1, 0), b3); PG8_STAGEB(PG8_SB(1, 1), b3 + hstepB); PG8_STAGE(PG8_SA(1, 0), a3, ca[0], ca[1]);
            PG8_WAIT_V(8); PG8_WAIT_L(0); PG8_BAR; PG8_MMA(1, 0, At, B0); PG8_MMA(1, 1, At, B1); PG8_BAR; PG8_SCHED;
        }
        if (PG8_ALIGN_EPI) { if (wr == 0) PG8_BAR; }
        if constexpr (FP8) asm volatile("s_nop 15\n\ts_nop 15" ::: "memory");
        if constexpr (!epi_after_drain<Epi>::value) E(acc, cur, wr, wc, fr, fq);
        if (!has_next) break;
#pragma unroll
        for (int a = 0; a < 2; ++a)
#pragma unroll
            for (int b = 0; b < 2; ++b)
#pragma unroll
                for (int m = 0; m < 4; ++m)
#pragma unroll
                    for (int n = 0; n < 2; ++n) acc[a][b][m][n] = (f32x4){0.f, 0.f, 0.f, 0.f};
        cur = nxt; cA = nA; cB = nB; ++ui;
        if (PG8_ALIGN_EPI) { if (wr == 1) PG8_BAR; }
    }
    PG8_WAIT_V(0);
    if (!PG8_ALIGN_EPI) { if (wr == 0) PG8_BAR; }
    PG8_BAR;
    if constexpr (epi_after_drain<Epi>::value) E.after(acc, cur, wr, wc, fr, fq, lds, lane);
#undef PG8_SA
#undef PG8_SB
#undef PG8_STAGE
#undef PG8_STAGEB
#undef PG8_LDA
#undef PG8_LD16
#undef PG8_LDB
#undef PG8_MMA
#undef PG8_WAIT_V
#undef PG8_WAIT_L
#undef PG8_BAR
#undef PG8_SCHED
}

struct DenseSched {
    const char* A; const char* Bt; int nM, nN, G, c; size_t astep, bstep; int nt;
    __device__ __forceinline__ bool next(int i, Unit& u) const { if (!tile_of((long)i * G + c, nM, nN, u.pm, u.pn)) return false; u.aux = 0; u.aux2 = -1; u.nt = nt; u.a = A + (size_t)u.pm * astep; u.b = Bt + (size_t)u.pn * bstep; return true; }
};
struct QkvbSched {
    const char* A; const char* Bt; int G, c;
    __device__ __forceinline__ bool next(int i, Unit& u) const { if (!tile_of((long)i * G + c, NTOK / 256, QKVB_N / 256, u.pm, u.pn)) return false; u.aux = 0; u.aux2 = -1;
        const bool kv = u.pn >= QW / 256; u.nt = kv ? 2 : 4; const size_t ko = kv ? (size_t)QL * 2 : 0;
        u.a = A + (size_t)u.pm * 256 * QKVB_K * 2 + ko; u.b = Bt + (size_t)u.pn * 256 * QKVB_K * 2 + ko; return true; }
};
struct GroupSched {
    const char* A; const char* Bt; int G, c; size_t agrp, bgrp, astep; int nt;
    __device__ __forceinline__ bool next(int i, Unit& u) const {
        const long L = (long)i * G + c; if (L >= 512) return false;
        const int xcd = (int)(L % 8), off = (int)(L / 8), w = xcd * 64 + off;
        u.aux = w >> 3; u.aux2 = -1; u.pm = w & 7; u.pn = 0; u.nt = nt; u.a = A + (size_t)u.aux * agrp + (size_t)u.pm * astep; u.b = Bt + (size_t)u.aux * bgrp; return true; }
};
struct MoeSched {
    const char* A; const char* Bt; const int* row_tok; int nN, G, c, nt; size_t astep, bexp, bstep; int rowb;
    int cnt[NEXP], ts[NEXP + 1];
    __device__ __forceinline__ void init(const unsigned* ecnt) {
        int t = 0;
#pragma unroll
        for (int e = 0; e < NEXP; ++e) { cnt[e] = (int)__builtin_amdgcn_readfirstlane(__hip_atomic_load(ecnt + 64 * e, __ATOMIC_RELAXED, __HIP_MEMORY_SCOPE_AGENT)); ts[e] = t; t += (cnt[e] + 255) >> 8; }
        ts[NEXP] = t;
    }
    __device__ __forceinline__ int expert_of(int T) const { int e = 0;
#pragma unroll
        for (int k = 1; k < NEXP; ++k) e += (T >= ts[k]) ? 1 : 0;
        return e; }
    __device__ __forceinline__ bool next(int i, Unit& u) const {
        if (!tile_of((long)i * G + c, ts[NEXP], nN, u.pm, u.pn)) return false;
        const int e = expert_of(u.pm); u.aux = e; u.aux2 = -1; u.nt = nt; u.a = A + (size_t)u.pm * astep; u.b = Bt + (size_t)e * bexp + (size_t)u.pn * bstep; return true; }
    __device__ __forceinline__ const int* idx_src(const Unit& u, int row) const {
        int tse = 0, ce = 0;
#pragma unroll
        for (int k = 0; k < NEXP; ++k) { tse = (u.aux == k) ? ts[k] : tse; ce = (u.aux == k) ? cnt[k] : ce; }
        int r = (u.pm - tse) * 256 + row; r = (r < ce) ? r : 0;
        return row_tok + u.aux * NTOK + r; }
    __device__ __forceinline__ unsigned off_of(int tok, int Ci) const { return (unsigned)tok * (unsigned)rowb + (unsigned)Ci * 2u; }
    __device__ __forceinline__ void gather(const Unit& u, const int (&R)[2], const int (&C)[2], unsigned (&off)[4]) const {
        int tok[4];
#pragma unroll
        for (int h = 0; h < 2; ++h)
#pragma unroll
            for (int i = 0; i < 2; ++i) tok[h * 2 + i] = *idx_src(u, h * HALF + R[i]);
#pragma unroll
        for (int h = 0; h < 2; ++h)
#pragma unroll
            for (int i = 0; i < 2; ++i) off[h * 2 + i] = off_of(tok[h * 2 + i], C[i]);
    }
};

constexpr int MOE_KS = 7;
struct MoeDownSched : MoeSched {
    int T0, ntail;
    __device__ __forceinline__ void init2() { const int T = ts[NEXP], per = (G % nN == 0) ? G / nN : 1; T0 = (T / per) * per; ntail = (T - T0) * nN * MOE_KS; }
    __device__ __forceinline__ bool next(int i, Unit& u) const {
        const long L = (long)i * G + c; const int nnorm = T0 * nN;
        if (L < nnorm) { tile_of(L, T0, nN, u.pm, u.pn); u.aux2 = -1; u.nt = nt; const int e = expert_of(u.pm); u.aux = e; u.a = A + (size_t)u.pm * astep; u.b = Bt + (size_t)e * bexp + (size_t)u.pn * bstep; return true; }
        const long L2 = L - nnorm; if (L2 >= ntail) return false;
        const int ks = (int)(L2 % MOE_KS), r = (int)(L2 / MOE_KS); u.pn = r % nN; u.pm = T0 + r / nN; u.aux2 = ks; u.nt = nt / MOE_KS;
        const int e = expert_of(u.pm); u.aux = e; const size_t ko = (size_t)ks * (nt / MOE_KS) * 128;
        u.a = A + (size_t)u.pm * astep + ko; u.b = Bt + (size_t)e * bexp + (size_t)u.pn * bstep + ko; return true; }
};
struct EpiMoeDown {
    static constexpr bool PERM = true;
    bf16* O; float* slab; int T0, tail_rows; float s;
    __device__ __forceinline__ void operator()(const f32x4 (&acc)[2][2][4][2], const Unit& u, int wr, int wc, int fr, int fq) const {
        const int col0 = u.pn * BM + wc * 32 + 8 * fq;
        if (u.aux2 < 0) { const int row0 = u.pm * BM + wr * 64 + fr;
#pragma unroll
            for (int ai = 0; ai < 2; ++ai)
#pragma unroll
                for (int m = 0; m < 4; ++m) { bf16* rowp = O + (size_t)(row0 + ai * HALF + m * 16) * D + col0;
#pragma unroll
                    for (int bj = 0; bj < 2; ++bj) { const f32x4 v0 = acc[ai][bj][m][0] * s, v1 = acc[ai][bj][m][1] * s;
                        u32x4 w; w.x = cvt_pk_bf16(v0[0], v0[1]); w.y = cvt_pk_bf16(v0[2], v0[3]); w.z = cvt_pk_bf16(v1[0], v1[1]); w.w = cvt_pk_bf16(v1[2], v1[3]);
                        *(u32x4*)(rowp + bj * HALF) = w; } }
        } else { const int row0 = u.aux2 * tail_rows + (u.pm - T0) * BM + wr * 64 + fr;
#pragma unroll
            for (int ai = 0; ai < 2; ++ai)
#pragma unroll
                for (int m = 0; m < 4; ++m) { float* rowp = slab + (size_t)(row0 + ai * HALF + m * 16) * D + col0;
#pragma unroll
                    for (int bj = 0; bj < 2; ++bj) { *(f32x4*)(rowp + bj * HALF) = acc[ai][bj][m][0] * s; *(f32x4*)(rowp + bj * HALF + 4) = acc[ai][bj][m][1] * s; } }
        }
    }
};

struct EpiF32 {
    static constexpr bool PERM = false;
    float* Cp; int ldc;
    __device__ __forceinline__ void operator()(const f32x4 (&acc)[2][2][4][2], const Unit& u, int wr, int wc, int fr, int fq) const {
        const int row0 = u.pm * BM + wr * 64 + fr, col0 = u.pn * BM + wc * 32 + 4 * fq;
#pragma unroll
        for (int ai = 0; ai < 2; ++ai)
#pragma unroll
            for (int m = 0; m < 4; ++m) { float* rowp = Cp + (size_t)(row0 + ai * HALF + m * 16) * ldc + col0;
#pragma unroll
                for (int bj = 0; bj < 2; ++bj)
#pragma unroll
                    for (int n = 0; n < 2; ++n) *(f32x4*)(rowp + bj * HALF + n * 16) = acc[ai][bj][m][n]; }
    }
};
struct EpiS1 {
    static constexpr bool PERM = false;
    float* Send;
    __device__ __forceinline__ void operator()(const f32x4 (&acc)[2][2][4][2], const Unit& u, int wr, int wc, int fr, int fq) const {
        float* base = Send + ((size_t)u.aux * NBC + u.pm * BM + wr * 64 + fr) * 128 + wc * 32 + 4 * fq;
#pragma unroll
        for (int ai = 0; ai < 2; ++ai)
#pragma unroll
            for (int m = 0; m < 4; ++m)
#pragma unroll
                for (int n = 0; n < 2; ++n) *(f32x4*)(base + (size_t)(ai * HALF + m * 16) * 128 + n * 16) = acc[ai][0][m][n];
    }
};
struct EpiS3 {
    static constexpr bool PERM = true;
    bf16* act;
    __device__ __forceinline__ void operator()(const f32x4 (&acc)[2][2][4][2], const Unit& u, int wr, int wc, int fr, int fq) const {
        const int g = u.aux;
#pragma unroll
        for (int ai = 0; ai < 2; ++ai)
#pragma unroll
            for (int m = 0; m < 4; ++m) { const int bc = u.pm * BM + ai * HALF + wr * 64 + m * 16 + fr, b = bc >> 7, c = bc & 127;
#pragma unroll
                for (int bj = 0; bj < 2; ++bj) { const int tl = 8 * bj + 2 * wc + (fq >> 1);
                    const f32x4 v0 = acc[ai][bj][m][0], v1 = acc[ai][bj][m][1];
                    u32x4 w; w.x = cvt_pk_bf16(gelu_tanh_f(v0[0]), gelu_tanh_f(v0[1])); w.y = cvt_pk_bf16(gelu_tanh_f(v0[2]), gelu_tanh_f(v0[3]));
                    w.z = cvt_pk_bf16(gelu_tanh_f(v1[0]), gelu_tanh_f(v1[1])); w.w = cvt_pk_bf16(gelu_tanh_f(v1[2]), gelu_tanh_f(v1[3]));
                    *(u32x4*)(act + (size_t)(b * SEQ + c * LCH + tl) * D + g * 16 + (fq & 1) * 8) = w; } }
    }
};
struct EpiGLU {
    static constexpr bool PERM = true;
    bf16* out;
    __device__ __forceinline__ void operator()(const f32x4 (&acc)[2][2][4][2], const Unit& u, int wr, int wc, int fr, int fq) const {
        const int row0 = u.pm * BM + wr * 64 + fr, col0 = u.pn * HALF + wc * 32 + 8 * fq;
#pragma unroll
        for (int ai = 0; ai < 2; ++ai)
#pragma unroll
            for (int m = 0; m < 4; ++m) { float h[8];
#pragma unroll
                for (int n = 0; n < 2; ++n)
#pragma unroll
                    for (int j = 0; j < 4; ++j) h[n * 4 + j] = acc[ai][0][m][n][j] * sigmoid_f(acc[ai][1][m][n][j]);
                u32x4 w; w.x = cvt_pk_bf16(h[0], h[1]); w.y = cvt_pk_bf16(h[2], h[3]); w.z = cvt_pk_bf16(h[4], h[5]); w.w = cvt_pk_bf16(h[6], h[7]);
                *(u32x4*)(out + (size_t)(row0 + ai * HALF + m * 16) * D + col0) = w; }
    }
};
struct EpiSwiGLU {
    static constexpr bool PERM = true;
    bf16* Hb; int ldh;
    __device__ __forceinline__ void operator()(const f32x4 (&acc)[2][2][4][2], const Unit& u, int wr, int wc, int fr, int fq) const {
        const int row0 = u.pm * BM + wr * 64 + fr, col0 = u.pn * HALF + wc * 32 + 8 * fq;
#pragma unroll
        for (int ai = 0; ai < 2; ++ai)
#pragma unroll
            for (int m = 0; m < 4; ++m) { float h[8];
#pragma unroll
                for (int n = 0; n < 2; ++n)
#pragma unroll
                    for (int j = 0; j < 4; ++j) { const float g = acc[ai][0][m][n][j], uu = acc[ai][1][m][n][j]; h[n * 4 + j] = g * sigmoid_f(g) * uu; }
                u32x4 w; w.x = cvt_pk_bf16(h[0], h[1]); w.y = cvt_pk_bf16(h[2], h[3]); w.z = cvt_pk_bf16(h[4], h[5]); w.w = cvt_pk_bf16(h[6], h[7]);
                *(u32x4*)(Hb + (size_t)(row0 + ai * HALF + m * 16) * ldh + col0) = w; }
    }
};
struct EpiSwiGLU8 {
    static constexpr bool PERM = true;
    fp8* Hq; int ldh; float s;
    __device__ __forceinline__ void operator()(const f32x4 (&acc)[2][2][4][2], const Unit& u, int wr, int wc, int fr, int fq) const {
        const int row0 = u.pm * BM + wr * 64 + fr, col0 = u.pn * HALF + wc * 32 + 8 * fq;
#pragma unroll
        for (int ai = 0; ai < 2; ++ai)
#pragma unroll
            for (int m = 0; m < 4; ++m) { float h[8];
#pragma unroll
                for (int n = 0; n < 2; ++n)
#pragma unroll
                    for (int jp = 0; jp < 2; ++jp) {
                        const f32x2 g2 = {acc[ai][0][m][n][2 * jp], acc[ai][0][m][n][2 * jp + 1]}, u2 = {acc[ai][1][m][n][2 * jp], acc[ai][1][m][n][2 * jp + 1]};
                        const f32x2 t2 = g2 * (-1.4426950408889634f * s);
                        f32x2 e2; e2.x = __builtin_amdgcn_exp2f(t2.x); e2.y = __builtin_amdgcn_exp2f(t2.y);
                        const f32x2 d2 = e2 + 1.0f;
                        f32x2 r2; r2.x = __builtin_amdgcn_rcpf(d2.x); r2.y = __builtin_amdgcn_rcpf(d2.y);
                        const f32x2 h2 = ((g2 * u2) * r2) * (s * s);
                        h[n * 4 + 2 * jp] = h2.x; h[n * 4 + 2 * jp + 1] = h2.y; }
                u32x2 w; w.x = pk4_fp8(h[0], h[1], h[2], h[3]); w.y = pk4_fp8(h[4], h[5], h[6], h[7]);
                *(u32x2*)(Hq + (size_t)(row0 + ai * HALF + m * 16) * ldh + col0) = w; }
    }
};
struct EpiBf16S {
    static constexpr bool PERM = true;
    bf16* O; int ldc; float s;
    __device__ __forceinline__ void operator()(const f32x4 (&acc)[2][2][4][2], const Unit& u, int wr, int wc, int fr, int fq) const {
        const int row0 = u.pm * BM + wr * 64 + fr, col0 = u.pn * BM + wc * 32 + 8 * fq;
#pragma unroll
        for (int ai = 0; ai < 2; ++ai)
#pragma unroll
            for (int m = 0; m < 4; ++m) { bf16* rowp = O + (size_t)(row0 + ai * HALF + m * 16) * ldc + col0;
#pragma unroll
                for (int bj = 0; bj < 2; ++bj) { const f32x4 v0 = acc[ai][bj][m][0] * s, v1 = acc[ai][bj][m][1] * s;
                    u32x4 w; w.x = cvt_pk_bf16(v0[0], v0[1]); w.y = cvt_pk_bf16(v0[2], v0[3]); w.z = cvt_pk_bf16(v1[0], v1[1]); w.w = cvt_pk_bf16(v1[2], v1[3]);
                    *(u32x4*)(rowp + bj * HALF) = w; } }
    }
};
struct EpiQkvaPrep {
    static constexpr bool PERM = false, AFTER_DRAIN = true;
    bf16* cqkv; bf16* krope; const float* qnorm; const float* kvnorm; const float* cosT; const float* sinT;
    __device__ __forceinline__ void operator()(const f32x4 (&)[2][2][4][2], const Unit&, int, int, int, int) const {}
    __device__ __forceinline__ void after(const f32x4 (&acc)[2][2][4][2], const Unit& u, int wr, int wc, int fr, int fq, LAS unsigned char* lds, int lane) const {
        LAS float* P = (LAS float*)lds;
        LAS float* RT = (LAS float*)(lds + 4096);
        const bool t1 = u.pn == 1; (void)lane;
#pragma unroll
        for (int ai = 0; ai < 2; ++ai)
#pragma unroll
            for (int m = 0; m < 4; ++m) { const int row = ai * HALF + wr * 64 + m * 16 + fr; float s = 0.f;
#pragma unroll
                for (int n = 0; n < 2; ++n) { const f32x4 a = acc[ai][0][m][n], b = acc[ai][1][m][n]; s += (a[0] * a[0] + a[1] * a[1]) + (a[2] * a[2] + a[3] * a[3]);
                    if (!t1) s += (b[0] * b[0] + b[1] * b[1]) + (b[2] * b[2] + b[3] * b[3]);
                    else if (wc < 2) *(LAS f32x4*)(RT + row * 64 + 32 * wc + 16 * n + 4 * fq) = b; }
                s += __shfl_xor(s, 16); s += __shfl_xor(s, 32);
                if (fq == 0) P[row * 4 + wc] = s; }
        asm volatile("s_waitcnt lgkmcnt(0)" ::: "memory"); __builtin_amdgcn_s_barrier(); asm volatile("" ::: "memory");
        const float* gn = t1 ? kvnorm : qnorm; const float inv_n = t1 ? (1.f / KVL) : (1.f / QL);
        f32x4 g[2][2];
#pragma unroll
        for (int bj = 0; bj < 2; ++bj)
#pragma unroll
            for (int n = 0; n < 2; ++n) g[bj][n] = (t1 && bj == 1) ? (f32x4){0.f, 0.f, 0.f, 0.f} : *(const f32x4*)(gn + bj * HALF + wc * 32 + n * 16 + 4 * fq);
#pragma unroll
        for (int ai = 0; ai < 2; ++ai)
#pragma unroll
            for (int m = 0; m < 4; ++m) { const int row = ai * HALF + wr * 64 + m * 16 + fr; const size_t grow = (size_t)u.pm * BM + row;
                const f32x4 pp = *(const LAS f32x4*)(P + row * 4); const float rstd = 1.f / sqrtf(((pp[0] + pp[1]) + (pp[2] + pp[3])) * inv_n + RMS_EPS);
                bf16* crow = cqkv + grow * QKVB_K + (t1 ? QL : 0) + wc * 32 + 4 * fq;
#pragma unroll
                for (int n = 0; n < 2; ++n) { const f32x4 a = acc[ai][0][m][n] * rstd * g[0][n]; u32x2 w; w.x = cvt_pk_bf16(a[0], a[1]); w.y = cvt_pk_bf16(a[2], a[3]); *(u32x2*)(crow + n * 16) = w;
                    if (!t1) { const f32x4 b = acc[ai][1][m][n] * rstd * g[1][n]; u32x2 w2; w2.x = cvt_pk_bf16(b[0], b[1]); w2.y = cvt_pk_bf16(b[2], b[3]); *(u32x2*)(crow + HALF + n * 16) = w2; }
                    else if (wc < 2) { const int i0 = 16 * n + 4 * fq, pos = (int)(grow & (SEQ - 1)); const f32x4 cs = *(const f32x4*)(cosT + pos * 32 + i0), sn = *(const f32x4*)(sinT + pos * 32 + i0);
                        const f32x4 mine = acc[ai][1][m][n], other = *(const LAS f32x4*)(RT + row * 64 + 32 * (1 - wc) + i0);
                        const f32x4 o = (wc == 0) ? (mine * cs - other * sn) : (other * sn + mine * cs);
                        u32x2 w3; w3.x = cvt_pk_bf16(o[0], o[1]); w3.y = cvt_pk_bf16(o[2], o[3]); *(u32x2*)(krope + grow * 64 + 32 * wc + i0) = w3; } } }
    }
};
struct EpiBf16 {
    static constexpr bool PERM = true;
    bf16* O; int ldc;
    __device__ __forceinline__ void operator()(const f32x4 (&acc)[2][2][4][2], const Unit& u, int wr, int wc, int fr, int fq) const {
        const int row0 = u.pm * BM + wr * 64 + fr, col0 = u.pn * BM + wc * 32 + 8 * fq;
#pragma unroll
        for (int ai = 0; ai < 2; ++ai)
#pragma unroll
            for (int m = 0; m < 4; ++m) { bf16* rowp = O + (size_t)(row0 + ai * HALF + m * 16) * ldc + col0;
#pragma unroll
                for (int bj = 0; bj < 2; ++bj) { const f32x4 v0 = acc[ai][bj][m][0], v1 = acc[ai][bj][m][1];
                    u32x4 w; w.x = cvt_pk_bf16(v0[0], v0[1]); w.y = cvt_pk_bf16(v0[2], v0[3]); w.z = cvt_pk_bf16(v1[0], v1[1]); w.w = cvt_pk_bf16(v1[2], v1[3]);
                    *(u32x4*)(rowp + bj * HALF) = w; } }
    }
};
}

namespace att {
constexpr int KVBLK = 64, QBLK = 32, QB = 256;
constexpr int SHM_V = KVBLK * 128 * 2, SHM_K = KVBLK * 128 * 2, SHM_R = KVBLK * 64 * 2;
constexpr int OFF_V = 0, OFF_K = 2 * SHM_V, OFF_R = OFF_K + 2 * SHM_K, OFF_WS = OFF_R + 2 * SHM_R, ATT_LDS = OFF_WS + 8 * 64 * 4;
constexpr float SCALE = 0.07216878364870322f;
constexpr float THR = 8.f;
#define KSWZ(row, colB) ((row) * 256 + ((colB) ^ (((row) & 7) << 4)))
#define RSWZ(row, colB) ((row) * 128 + ((colB) ^ (((row) & 7) << 4)))
#define SBAR() __builtin_amdgcn_sched_barrier(0)
__device__ __forceinline__ int v_st(int k, int c) { const int kk = (k & ~0xC) | ((k & 4) << 1) | ((k & 8) >> 1); return ((kk >> 3) * 4 + (c >> 5)) * 512 + ((kk & 7) * 32 + (c & 31)) * 2; }
__device__ __forceinline__ int v_rd_base(int lane) { return ((lane & 3) << 3) | (((lane >> 2) & 3) << 6) | (((lane >> 4) & 1) << 5) | (((lane >> 5) & 1) << 8); }
constexpr int v_rd_off(int d0, int ks, int half) { return d0 * 512 + ks * 4096 + half * 2048; }
__device__ __forceinline__ int crow(int r, int hi) { return (r & 3) + 8 * (r >> 2) + 4 * hi; }
__device__ __forceinline__ void mask_tile(f32x16& p0, f32x16& p1, int dq) {
    const float NEG = -__builtin_inff();
#pragma unroll
    for (int r = 0; r < 16; ++r) {
        const int c = (r & 3) + 8 * (r >> 2);
        if (dq - c < 0) p0[r] = NEG;
        if (dq - c - 32 < 0) p1[r] = NEG;
    }
}
__device__ __forceinline__ void partialSM(f32x16& p0, f32x16& p1, float& m_reg, float& mn, float& alpha) {
    float pmax = p0[0];
#pragma unroll
    for (int r = 1; r < 16; ++r) pmax = fmaxf(pmax, p0[r]);
#pragma unroll
    for (int r = 0; r < 16; ++r) pmax = fmaxf(pmax, p1[r]);
    { auto rr = __builtin_amdgcn_permlane32_swap(__float_as_uint(pmax), __float_as_uint(pmax), false, false);
      pmax = fmaxf(__uint_as_float(rr[0]), __uint_as_float(rr[1])); }
    constexpr float C2 = 1.4426950408889634f * SCALE;
    if (__builtin_expect(__all((pmax - m_reg) * SCALE <= THR), 1)) { mn = m_reg; alpha = 1.f; }
    else { mn = fmaxf(m_reg, pmax); alpha = __builtin_amdgcn_exp2f((m_reg - mn) * C2); m_reg = mn; }
    const float mnL = -mn * C2;
#pragma unroll
    for (int r = 0; r < 16; ++r) p0[r] = __builtin_amdgcn_exp2f(fmaf(p0[r], C2, mnL));
#pragma unroll
    for (int r = 0; r < 16; ++r) p1[r] = __builtin_amdgcn_exp2f(fmaf(p1[r], C2, mnL));
}
__device__ __forceinline__ void finishSM(f32x16& p0, f32x16& p1, float alpha, float& l_reg, bf16x8& pa0, bf16x8& pa1, bf16x8& pa2, bf16x8& pa3) {
    float ps = 0;
#pragma unroll
    for (int r = 0; r < 16; ++r) ps += p0[r];
#pragma unroll
    for (int r = 0; r < 16; ++r) ps += p1[r];
    { auto rr = __builtin_amdgcn_permlane32_swap(__float_as_uint(ps), __float_as_uint(ps), false, false);
      ps = __uint_as_float(rr[0]) + __uint_as_float(rr[1]); }
    l_reg = l_reg * alpha + ps;
#define PK4(P, B_, OUT) do { unsigned a0 = cvt_pk_bf16(P[B_+0], P[B_+1]), a1 = cvt_pk_bf16(P[B_+2], P[B_+3]);                          \
        unsigned b0 = cvt_pk_bf16(P[B_+4], P[B_+5]), b1 = cvt_pk_bf16(P[B_+6], P[B_+7]);                                             \
        auto r0 = __builtin_amdgcn_permlane32_swap(a0, b0, false, false); auto r1 = __builtin_amdgcn_permlane32_swap(a1, b1, false, false); \
        u32x4 w = {r0[0], r1[0], r0[1], r1[1]}; OUT = *reinterpret_cast<bf16x8*>(&w); } while (0)
    PK4(p0, 0, pa0); PK4(p0, 8, pa1); PK4(p1, 0, pa2); PK4(p1, 8, pa3);
#undef PK4
}
template <int KB>
__device__ __forceinline__ void qkt(f32x16& p0, f32x16& p1, const char* lds, int r32, int hi, const bf16x8* qr) {
    p0 = f32x16{}; p1 = f32x16{};
    const char* kb[4]; const char* kr[4];
#pragma unroll
    for (int dd = 0; dd < 4; ++dd) { kb[dd] = lds + OFF_K + KB * SHM_K + KSWZ(r32, (dd * 16 + hi * 8) * 2); kr[dd] = lds + OFF_R + KB * SHM_R + RSWZ(r32, (dd * 16 + hi * 8) * 2); }
#pragma unroll
    for (int d0 = 0; d0 < 8; ++d0) { const char* a = kb[d0 & 3] + (d0 >> 2) * 128;
        bf16x8 b0 = *reinterpret_cast<const bf16x8*>(a);
        bf16x8 b1 = *reinterpret_cast<const bf16x8*>(a + 32 * 256);
        p0 = __builtin_amdgcn_mfma_f32_32x32x16_bf16(b0, qr[d0], p0, 0, 0, 0);
        p1 = __builtin_amdgcn_mfma_f32_32x32x16_bf16(b1, qr[d0], p1, 0, 0, 0); }
#pragma unroll
    for (int d0 = 0; d0 < 4; ++d0) { const char* a = kr[d0];
        bf16x8 b0 = *reinterpret_cast<const bf16x8*>(a);
        bf16x8 b1 = *reinterpret_cast<const bf16x8*>(a + 32 * 128);
        p0 = __builtin_amdgcn_mfma_f32_32x32x16_bf16(b0, qr[8 + d0], p0, 0, 0, 0);
        p1 = __builtin_amdgcn_mfma_f32_32x32x16_bf16(b1, qr[8 + d0], p1, 0, 0, 0); }
}
template <int VB>
__device__ __forceinline__ void pv_tile(f32x16* o, int vb0, bf16x8 pa0, bf16x8 pa1, bf16x8 pa2, bf16x8 pa3) {
#define TRRD(dst, off) asm volatile("ds_read_b64_tr_b16 %0, %1 offset:%2" : "=&v"(dst) : "v"(vb0), "i"(off) : "memory")
#define PV_D0(d0) do { s16x4 l0, l1, l2, l3, h0, h1, h2, h3; constexpr int b_ = OFF_V + VB * SHM_V + v_rd_off(d0, 0, 0); \
        TRRD(l0, b_); TRRD(h0, b_ + 2048); TRRD(l1, b_ + 4096); TRRD(h1, b_ + 6144); TRRD(l2, b_ + 8192); TRRD(h2, b_ + 10240); TRRD(l3, b_ + 12288); TRRD(h3, b_ + 14336); \
        asm volatile("s_waitcnt lgkmcnt(0)" ::: "memory"); SBAR();   \
        o[d0] = __builtin_amdgcn_mfma_f32_32x32x16_bf16(pa0, (bf16x8){l0[0], l0[1], l0[2], l0[3], h0[0], h0[1], h0[2], h0[3]}, o[d0], 0, 0, 0);   \
        o[d0] = __builtin_amdgcn_mfma_f32_32x32x16_bf16(pa1, (bf16x8){l1[0], l1[1], l1[2], l1[3], h1[0], h1[1], h1[2], h1[3]}, o[d0], 0, 0, 0);   \
        o[d0] = __builtin_amdgcn_mfma_f32_32x32x16_bf16(pa2, (bf16x8){l2[0], l2[1], l2[2], l2[3], h2[0], h2[1], h2[2], h2[3]}, o[d0], 0, 0, 0);   \
        o[d0] = __builtin_amdgcn_mfma_f32_32x32x16_bf16(pa3, (bf16x8){l3[0], l3[1], l3[2], l3[3], h3[0], h3[1], h3[2], h3[3]}, o[d0], 0, 0, 0); } while (0)
    PV_D0(0); PV_D0(1); PV_D0(2); PV_D0(3);
#undef PV_D0
#undef TRRD
}
constexpr int OFF_CONV = 86016, CONV_BUF = 16384  , CONV_NB = 2 * EXD / 32  , CONV_KSTRIDE = 128 * 2 * EXD * 4  ;
struct Conv { const float* src; unsigned char* dst; int cs, G, bx, cb, pend; };
struct ConvLane { unsigned voff0, voff1, ldsE, ldsO, dstoff, sel; };
__device__ __forceinline__ ConvLane conv_lane(int wid, int lane) {
    ConvLane cl; const int kg = lane & 15, q = lane >> 4, hh = (lane >> 3) & 1;
    cl.voff0 = (unsigned)(((wid * 16 + (lane >> 3)) * (2 * EXD) + (((lane & 7) ^ ((wid * 2) & 7)) * 4)) * 4);
    cl.voff1 = (unsigned)(((wid * 16 + 8 + (lane >> 3)) * (2 * EXD) + (((lane & 7) ^ ((wid * 2 + 1) & 7)) * 4)) * 4);
    const int base = OFF_CONV + kg * 1024 + ((wid ^ (kg & 7)) * 16) + q * 4;
    cl.ldsE = (unsigned)(base + hh * 128); cl.ldsO = (unsigned)(base - hh * 128);
    cl.dstoff = (unsigned)((4 * wid + q) * D + 8 * kg);
    cl.sel = hh ? 0x02030001u : 0x03020100u;
    asm volatile("" : "+v"(cl.voff0), "+v"(cl.voff1), "+v"(cl.ldsE), "+v"(cl.ldsO), "+v"(cl.dstoff), "+v"(cl.sel));
    return cl;
}
__device__ __forceinline__ bool conv_valid(const Conv& cv, int q) { return cv.bx + (q >> 6) * cv.G < CONV_NB; }
__device__ __forceinline__ void conv_issue(const Conv& cv, const ConvLane& cl, int q, int buf, LAS unsigned char* ldsl, int wid) {
    const unsigned nbi = (unsigned)(cv.bx + (q >> 6) * cv.G), sk = (unsigned)(q & 63);
    const char* s0 = (const char*)cv.src + ((size_t)sk * CONV_KSTRIDE + nbi * 128);
    __builtin_amdgcn_global_load_lds((const unsigned*)(s0 + cl.voff0), (LAS unsigned*)(ldsl + OFF_CONV + buf * CONV_BUF + wid * 2048), 16, 0, 2);
    __builtin_amdgcn_global_load_lds((const unsigned*)(s0 + cl.voff1), (LAS unsigned*)(ldsl + OFF_CONV + buf * CONV_BUF + wid * 2048 + 1024), 16, 0, 2);
}
struct ConvRegs { float a0, a1, a2, a3, b0, b1, b2, b3; };
__device__ __forceinline__ void conv_load(ConvRegs& r, const ConvLane& cl, int buf, LAS unsigned char* ldsl) {
    const LAS float* pE = (const LAS float*)(ldsl + buf * CONV_BUF + cl.ldsE); const LAS float* pO = (const LAS float*)(ldsl + buf * CONV_BUF + cl.ldsO);
    r.a0 = pE[0]; r.a1 = pE[64]; r.a2 = pE[128]; r.a3 = pE[192]; r.b0 = pO[32]; r.b1 = pO[96]; r.b2 = pO[160]; r.b3 = pO[224];
}
__device__ __forceinline__ void conv_finish(const ConvRegs& r, const Conv& cv, const ConvLane& cl, int q) {
    const unsigned nbi = (unsigned)(cv.bx + (q >> 6) * cv.G), sk = (unsigned)(q & 63);
    const unsigned n0 = nbi * 32, up = (n0 >= (unsigned)EXD) ? 1u : 0u, n1 = n0 - up * EXD, drow0 = (n1 >> 7) * 256 + (n1 & 127) + up * 128;
    const unsigned lo = pk4_fp8(r.a0 * MOE_SC_IN, r.b0 * MOE_SC_IN, r.a1 * MOE_SC_IN, r.b1 * MOE_SC_IN), hi2 = pk4_fp8(r.a2 * MOE_SC_IN, r.b2 * MOE_SC_IN, r.a3 * MOE_SC_IN, r.b3 * MOE_SC_IN);
    u32x2 o; o.x = __builtin_amdgcn_perm(lo, lo, cl.sel); o.y = __builtin_amdgcn_perm(hi2, hi2, cl.sel);
    unsigned char* d0 = cv.dst + ((size_t)(sk >> 3) * ((size_t)2 * EXD * D) + (size_t)drow0 * D + (sk & 7) * 128);
    __builtin_nontemporal_store(o, (GAS u32x2*)(d0 + cl.dstoff));
}
__device__ __forceinline__ void conv_tail(const ConvRegs& r, bool have, Conv& cv, const ConvLane& cl, LAS unsigned char* ldsl, int wid) {
    if (have) conv_finish(r, cv, cl, cv.cs);
    const int nb = (cv.cb == 0) ? 2 : cv.cb - 1;
    cv.pend = conv_valid(cv, cv.cs + 2) ? 1 : 0;
    if (cv.pend) conv_issue(cv, cl, cv.cs + 2, nb, ldsl, wid);
    ++cv.cs; cv.cb = (cv.cb == 2) ? 0 : cv.cb + 1;
}
__device__ __forceinline__ void conv_drain(Conv& cv, LAS unsigned char* ldsl) {
    int tid_ = threadIdx.x; asm volatile("" : "+v"(tid_));
    const int wid = __builtin_amdgcn_readfirstlane(tid_ >> 6), lane = tid_ & 63;
    const ConvLane cl = conv_lane(wid, lane);
    while (conv_valid(cv, cv.cs)) { asm volatile("s_waitcnt vmcnt(0)" ::: "memory"); __syncthreads(); ConvRegs r; conv_load(r, cl, cv.cb, ldsl); conv_tail(r, true, cv, cl, ldsl, wid); }
}
template <int QP, int KP>
__device__ __forceinline__ void attn_block(const bf16* Qp, const bf16* Kp, const bf16* Vp, const bf16* Rp, bf16* Op, int P0, const float* cosT, const float* sinT, char* lds, LAS unsigned char* ldsl, Conv& cv) {
    int tid_ = threadIdx.x; asm volatile("" : "+v"(tid_));
    const int tid = tid_, wid = __builtin_amdgcn_readfirstlane(tid >> 6), lane = tid & 63, r32 = lane & 31, hi = lane >> 5;
    const int NT = (P0 + QB) / KVBLK;
    const int qlo = P0 + wid * QBLK, qm = qlo + r32 - 4 * hi;
    float* wsf = (float*)(lds + OFF_WS) + wid * 64; float* li_l = wsf; float* al_l = wsf + 32;
        const int vb0 = (int)(uintptr_t)lds + v_rd_base(lane);
    bf16x8 qr[12];
    { const bf16* qrow = Qp + (size_t)(wid * QBLK + r32) * QP + hi * 8;
#pragma unroll
      for (int d0 = 0; d0 < 12; ++d0) qr[d0] = *reinterpret_cast<const bf16x8*>(qrow + d0 * 16);
      const float* cr = cosT + (size_t)(qlo + r32) * 32 + hi * 8; const float* sn = sinT + (size_t)(qlo + r32) * 32 + hi * 8;
#pragma unroll
      for (int x = 0; x < 2; ++x) { const f32x4 c0 = *(const f32x4*)(cr + x * 16), c1 = *(const f32x4*)(cr + x * 16 + 4), s0 = *(const f32x4*)(sn + x * 16), s1 = *(const f32x4*)(sn + x * 16 + 4);
          const u32x4 a = *reinterpret_cast<const u32x4*>(&qr[8 + x]), b = *reinterpret_cast<const u32x4*>(&qr[10 + x]); u32x4 oa, ob;
#pragma unroll
          for (int e = 0; e < 4; ++e) { const float t1l = bf_lo(a[e]), t1h = bf_hi(a[e]), t2l = bf_lo(b[e]), t2h = bf_hi(b[e]);
              const float cl = (e < 2) ? c0[2 * e] : c1[2 * e - 4], ch = (e < 2) ? c0[2 * e + 1] : c1[2 * e - 3], sl = (e < 2) ? s0[2 * e] : s1[2 * e - 4], sh = (e < 2) ? s0[2 * e + 1] : s1[2 * e - 3];
              oa[e] = cvt_pk_bf16(t1l * cl - t2l * sl, t1h * ch - t2h * sh); ob[e] = cvt_pk_bf16(t1l * sl + t2l * cl, t1h * sh + t2h * ch); }
          qr[8 + x] = *reinterpret_cast<const bf16x8*>(&oa); qr[10 + x] = *reinterpret_cast<const bf16x8*>(&ob); } }
    float m_reg = -1e30f, l_reg = 0; f32x16 o[4] = {};
    int kofs, vofs, rofs;
    { const int L = wid * 1024 + lane * 16;
        { const int row = L >> 8, colB = (L & 255) ^ ((row & 7) << 4); kofs = row * KP + (colB >> 1); }
        { const int sub = L >> 9, kkh = sub >> 2, cblk = sub & 3, w = (L & 511) >> 1, kk = kkh * 8 + (w >> 5), k = (kk & ~0xC) | ((kk & 4) << 1) | ((kk & 8) >> 1); vofs = k * KP + cblk * 32 + (w & 31); }
        { const int row = L >> 7, colB = (L & 127) ^ ((row & 7) << 4); rofs = row * 64 + (colB >> 1); } }
#define SLOAD(k0, bf) do { \
        __builtin_amdgcn_global_load_lds((const unsigned*)(Kp + (size_t)(k0) * KP + kofs), (LAS unsigned*)(ldsl + OFF_K + (bf) * SHM_K + wid * 1024), 16, 0, 0); \
        __builtin_amdgcn_global_load_lds((const unsigned*)(Kp + (size_t)((k0) + 32) * KP + kofs), (LAS unsigned*)(ldsl + OFF_K + (bf) * SHM_K + 8192 + wid * 1024), 16, 0, 0); \
        __builtin_amdgcn_global_load_lds((const unsigned*)(Vp + (size_t)(k0) * KP + vofs), (LAS unsigned*)(ldsl + OFF_V + (bf) * SHM_V + wid * 1024), 16, 0, 0); \
        __builtin_amdgcn_global_load_lds((const unsigned*)(Vp + (size_t)((k0) + 32) * KP + vofs), (LAS unsigned*)(ldsl + OFF_V + (bf) * SHM_V + 8192 + wid * 1024), 16, 0, 0); \
        __builtin_amdgcn_global_load_lds((const unsigned*)(Rp + (size_t)(k0) * 64 + rofs), (LAS unsigned*)(ldsl + OFF_R + (bf) * SHM_R + wid * 1024), 16, 0, 0); } while (0)
#define RESC(a) do { if (__any((a) < 1.f)) { if (hi == 0) al_l[r32] = (a); asm volatile("s_waitcnt lgkmcnt(0)" ::: "memory");              \
                     for (int d_ = 0; d_ < 4; ++d_) for (int r = 0; r < 16; ++r) o[d_][r] *= al_l[crow(r, hi)]; } } while (0)
#define STEP(t, BF) do { const int kb_ = (t) * KVBLK;                                                                            \
        if (CONV_IN_ATTN && (t) > 0 && cv.pend) asm volatile("s_waitcnt vmcnt(2)" ::: "memory"); else asm volatile("s_waitcnt vmcnt(0)" ::: "memory");       \
        asm volatile("s_waitcnt lgkmcnt(0)" ::: "memory"); __builtin_amdgcn_s_barrier(); asm volatile("" ::: "memory");     \
        if ((t) + 1 < NT) SLOAD(kb_ + KVBLK, 1 - (BF));                                                                         \
        const bool chave_ = CONV_IN_ATTN && conv_valid(cv, cv.cs);                                                                \
        if (kb_ <= qlo + QBLK - 1) { f32x16 p0, p1; float mn, al; bf16x8 pa0, pa1, pa2, pa3;                                     \
            qkt<BF>(p0, p1, lds, r32, hi, qr);                                                                                   \
            if (kb_ + KVBLK - 1 > qlo) mask_tile(p0, p1, qm - kb_);                                                              \
            partialSM(p0, p1, m_reg, mn, al); RESC(al);                                                                          \
            finishSM(p0, p1, al, l_reg, pa0, pa1, pa2, pa3); SBAR();                                                             \
            pv_tile<BF>(o, vb0, pa0, pa1, pa2, pa3); }                                                                           \
        if (CONV_IN_ATTN) { ConvRegs cr_; if (chave_) conv_load(cr_, cl, cv.cb, ldsl); conv_tail(cr_, chave_, cv, cl, ldsl, wid); } } while (0)
    __syncthreads();
    SLOAD(0, 0);
    const ConvLane cl = conv_lane(wid, lane);
    if (CONV_IN_ATTN && cv.cs == 0) { if (conv_valid(cv, 0)) conv_issue(cv, cl, 0, 0, ldsl, wid); if (conv_valid(cv, 1)) conv_issue(cv, cl, 1, 1, ldsl, wid); }
    for (int t = 0; t < NT; t += 2) { STEP(t, 0); STEP(t + 1, 1); }
    if (hi == 0) li_l[r32] = l_reg; asm volatile("s_waitcnt lgkmcnt(0)" ::: "memory");
    bf16* Ow = Op + (size_t)(wid * QBLK) * D;
#pragma unroll
    for (int r = 0; r < 16; ++r) { const int orow = crow(r, hi); const float rl = __builtin_amdgcn_rcpf(li_l[orow]);
#pragma unroll
        for (int d0 = 0; d0 < 4; ++d0) { const float v = o[d0][r] * rl; const float vn = __shfl_xor(v, 1);
            if ((r32 & 1) == 0) *(unsigned*)(Ow + (size_t)orow * D + d0 * 32 + r32) = cvt_pk_bf16(v, vn); } }
#undef SLOAD
#undef RESC
#undef STEP
}
}

#define XB_TMO      128
#define XB_XCNT(j)  (256  + 64 * (j))
#define XB_XSUB(j)  (1280 + 64 * (j))
#define XB_XGEN(j)  (2304 + 64 * (j))
#define XB_TOP      3328
#define XB_TOPGEN   3392
#define XCD_BAR_WORDS 3456
#define XB_SPIN_CAP (1u << 22)
__device__ __forceinline__ unsigned xb_ld(unsigned* p)              { return __hip_atomic_load(p, __ATOMIC_RELAXED, __HIP_MEMORY_SCOPE_AGENT); }
__device__ __forceinline__ unsigned xb_add(unsigned* p, unsigned v) { return __hip_atomic_fetch_add(p, v, __ATOMIC_RELAXED, __HIP_MEMORY_SCOPE_AGENT); }
__device__ __forceinline__ unsigned xb_xcc_id() { return (unsigned)__builtin_amdgcn_s_getreg((3 << 11) | 20) & 0xFu; }
#define XB_SPIN(cond, bar) do { unsigned _sp = 0; while (cond) { __builtin_amdgcn_s_sleep(1); \
    if ((++_sp & 255u) == 0u) { if (xb_ld(&(bar)[XB_TMO])) break; if (_sp > XB_SPIN_CAP) { atomicAdd(&(bar)[XB_TMO], 1u); break; } } } } while (0)
struct XcdBarrier { unsigned* bar; unsigned x; volatile LAS unsigned* st; };
__device__ __forceinline__ XcdBarrier xcd_barrier_post(unsigned* bar, volatile LAS unsigned* st) {
    XcdBarrier b; b.bar = bar; b.x = xb_xcc_id(); b.st = st;
    if (threadIdx.x == 0) (void)xb_add(&bar[XB_XCNT(b.x)], 1u);
    return b;
}
__device__ __forceinline__ void xcd_barrier_complete(unsigned* bar, unsigned x, unsigned& nloc, unsigned& nx) {
    const unsigned G = gridDim.x * gridDim.y * gridDim.z;
    unsigned sum, cnt, mine, sp = 0u;
    for (;;) {
        sum = 0u; cnt = 0u; mine = 0u;
#pragma unroll
        for (unsigned j = 0; j < 16; ++j) { const unsigned c = xb_ld(&bar[XB_XCNT(j)]); sum += c; cnt += (c > 0u) ? 1u : 0u; mine = (j == x) ? c : mine; }
        if (sum == G) break;
        __builtin_amdgcn_s_sleep(1);
        if ((++sp & 255u) == 0u) { if (xb_ld(&bar[XB_TMO])) break; if (sp > XB_SPIN_CAP) { atomicAdd(&bar[XB_TMO], 1u); break; } }
    }
    nloc = mine > 0u ? mine : 1u; nx = cnt > 0u ? cnt : 1u;
}
__device__ __forceinline__ void xcd_barrier(const XcdBarrier& b) {
    asm volatile("s_waitcnt vmcnt(0)" ::: "memory");
    __syncthreads();
    if (threadIdx.x == 0) {
        unsigned* bar = b.bar;
        __builtin_amdgcn_s_waitcnt(0);
        unsigned nloc = b.st[0], nx = b.st[1];
        if (nloc == 0u) { xcd_barrier_complete(bar, b.x, nloc, nx); b.st[0] = nloc; b.st[1] = nx; }
        const unsigned old = xb_add(&bar[XB_XSUB(b.x)], 1u);
        const unsigned gen = old / nloc;
        if (old + 1u == (gen + 1u) * nloc) {
            __builtin_amdgcn_fence(__ATOMIC_RELEASE, "agent");
            asm volatile("s_waitcnt vmcnt(0)" ::: "memory");
            const unsigned og = xb_add(&bar[XB_TOP], 1u);
            const unsigned tg = og / nx;
            if (og + 1u == (tg + 1u) * nx) xb_add(&bar[XB_TOPGEN], 1u);
            else XB_SPIN(xb_ld(&bar[XB_TOPGEN]) == tg, bar);
            __builtin_amdgcn_fence(__ATOMIC_ACQUIRE, "agent");
            xb_add(&bar[XB_XGEN(b.x)], 1u);
            asm volatile("s_waitcnt vmcnt(0)" ::: "memory");
        } else {
            XB_SPIN(xb_ld(&bar[XB_XGEN(b.x)]) == gen, bar);
            __builtin_amdgcn_fence(__ATOMIC_ACQUIRE, "agent");
            asm volatile("s_waitcnt vmcnt(0)" ::: "memory");
        }
    }
    __syncthreads();
}

struct Args { const float* in[24]; float* out; unsigned char* ws; int ph_lo, ph_hi, li, pad; };
enum In { I_X = 0, I_LAMRE, I_LAMIM, I_LOGSTEP, I_BRE, I_BIM, I_CRE, I_CIM, I_SD, I_WGLU, I_QWA, I_QNORM, I_QWB, I_OW, I_KVWA, I_KVNORM, I_KVWB, I_FFNIN, I_FFNOUT, I_ROUTER, I_MOEIN, I_MOEOUT, I_LNG, I_LNB };

__device__ __forceinline__ void tr_item(const float* W, int N, bf16* WT, int ldk, int k0, int n0, int drow0, int dk0, LAS float* scr, int lane) {
    { const int r4 = lane >> 4, c4 = (lane & 15) * 4;
      f32x4 v[16];
#pragma unroll
      for (int i = 0; i < 16; ++i) v[i] = __builtin_nontemporal_load((const GAS f32x4*)(W + (size_t)(k0 + 4 * i + r4) * N + n0 + c4));
#pragma unroll
      for (int i = 0; i < 16; ++i) { LAS float* d = scr + (4 * i + r4) * 65 + c4; d[0] = v[i][0]; d[1] = v[i][1]; d[2] = v[i][2]; d[3] = v[i][3]; } }
    LDS_WAIT(); asm volatile("" ::: "memory");
    const int c = lane & 7;
#pragma unroll
    for (int jj = 0; jj < 8; ++jj) { const int n = (lane >> 3) + 8 * jj; const LAS float* s = scr + (8 * c) * 65 + n;
        u32x4 o; o.x = cvt_pk_bf16(s[0 * 65], s[1 * 65]); o.y = cvt_pk_bf16(s[2 * 65], s[3 * 65]); o.z = cvt_pk_bf16(s[4 * 65], s[5 * 65]); o.w = cvt_pk_bf16(s[6 * 65], s[7 * 65]);
        __builtin_nontemporal_store(o, (GAS u32x4*)(WT + (size_t)(drow0 + n) * ldk + dk0 + k0 + 8 * c)); }
    LDS_WAIT(); asm volatile("" ::: "memory");
}
__device__ __forceinline__ void tr_item8(const float* W, int N, fp8* WT, int ldk, int k0, int n0, int drow0, float sc, LAS float* scr, int lane) {
    { const int r4 = lane >> 4, c4 = (lane & 15) * 4;
      f32x4 v[16];
#pragma unroll
      for (int i = 0; i < 16; ++i) v[i] = __builtin_nontemporal_load((const GAS f32x4*)(W + (size_t)(k0 + 4 * i + r4) * N + n0 + c4));
#pragma unroll
      for (int i = 0; i < 16; ++i) { LAS float* d = scr + (4 * i + r4) * 65 + c4; d[0] = v[i][0] * sc; d[1] = v[i][1] * sc; d[2] = v[i][2] * sc; d[3] = v[i][3] * sc; } }
    LDS_WAIT(); asm volatile("" ::: "memory");
    const int c = lane & 3;
#pragma unroll
    for (int jj = 0; jj < 4; ++jj) { const int n = (lane >> 2) + 16 * jj; const LAS float* s = scr + (16 * c) * 65 + n;
        u32x4 o; o.x = pk4_fp8(s[0 * 65], s[1 * 65], s[2 * 65], s[3 * 65]); o.y = pk4_fp8(s[4 * 65], s[5 * 65], s[6 * 65], s[7 * 65]);
        o.z = pk4_fp8(s[8 * 65], s[9 * 65], s[10 * 65], s[11 * 65]); o.w = pk4_fp8(s[12 * 65], s[13 * 65], s[14 * 65], s[15 * 65]);
        __builtin_nontemporal_store(o, (GAS u32x4*)(WT + (size_t)(drow0 + n) * ldk + k0 + 16 * c)); }
    LDS_WAIT(); asm volatile("" ::: "memory");
}
__device__ __forceinline__ void tr_matrix_item8(const float* W, int N, fp8* WT, int ldk, int ilv, float sc, LAS float* scr, int item, int lane) {
    const int nb = N / 64, kb = item / nb, nbi = item % nb, n0 = nbi * 64;
    int drow = n0;
    if (ilv > 0) { const int n1 = (n0 >= ilv) ? n0 - ilv : n0; drow = (n1 >> 7) * 256 + (n1 & 127) + ((n0 >= ilv) ? 128 : 0); }
    tr_item8(W, N, WT, ldk, kb * 128, n0, drow, sc, scr, lane); tr_item8(W, N, WT, ldk, kb * 128 + 64, n0, drow, sc, scr, lane);
}
__device__ __forceinline__ void tr_matrix_item(const float* W, int K, int N, bf16* WT, int ldk, int drow_base, int dk0, int ilv, LAS float* scr, int item, int lane) {
    const int nb = N / 64, kb = item / nb, nbi = item % nb, n0 = nbi * 64; (void)K;
    int drow = n0;
    if (ilv > 0) { const int n1 = (n0 >= ilv) ? n0 - ilv : n0; drow = (n1 >> 7) * 256 + (n1 & 127) + ((n0 >= ilv) ? 128 : 0); }
    tr_item(W, N, WT, ldk, kb * 64, n0, drow_base + drow, dk0, scr, lane);
}

__global__ void __launch_bounds__(NWAVES * 64, 2) yoco_fwd(Args args) {
    extern __shared__ __attribute__((aligned(16))) unsigned char lds_raw[];
    LAS unsigned char* lds = (LAS unsigned char*)lds_raw;
    volatile LAS unsigned* MISC = (volatile LAS unsigned*)(lds + MISC_OFF);
    const int G = gridDim.x; const int bx = blockIdx.x; const int vcu = (G % 8 == 0) ? (bx % 8) * (G / 8) + bx / 8 : bx;
    const int NGW = G * NWAVES;
#define PHASE_IDS() int tid = threadIdx.x; asm volatile("" : "+v"(tid)); const int lane = tid & 63, wave = __builtin_amdgcn_readfirstlane(tid >> 6); const int gw = vcu * NWAVES + wave; (void)gw; (void)lane
    unsigned char* ws = args.ws;
    GAS unsigned* ctl = (GAS unsigned*)(ws + WS_CTL);
    for (int u = threadIdx.x; u < (LDS_BYTES - LDSCTL_OFF) / 4; u += NWAVES * 64) ((LAS unsigned*)(lds + LDSCTL_OFF))[u] = 0u;
    __syncthreads();
    XcdBarrier bar; bar.bar = (unsigned*)(ws + WS_CTL) + CW_BAR; bar.x = 0; bar.st = nullptr;
    if (MK_N_LAUNCHES == 1) bar = xcd_barrier_post((unsigned*)(ws + WS_CTL) + CW_BAR, MISC + 8);
#define GRID_BAR() do { if (MK_N_LAUNCHES == 1) xcd_barrier(bar); } while (0)
    const int lo = args.ph_lo, hi_ph = args.ph_hi;
#ifndef PH_MASK
#define PH_MASK 0x3ffffff
#endif
#define IN(k) (((PH_MASK >> (k)) & 1) && lo <= (k) && (k) < hi_ph)
#define BOTH(k) (IN(k) && IN((k) + 1))

    const float* x_in = args.in[I_X];
    bf16* W_MOEIN = (bf16*)(ws + WS_MOEIN); bf16* W_MOEOUT = (bf16*)(ws + WS_MOEOUT); bf16* W_FFNIN = (bf16*)(ws + WS_FFNIN); bf16* W_FFNOUT = (bf16*)(ws + WS_FFNOUT);
    bf16* W_GLU = (bf16*)(ws + WS_GLU); bf16* W_OW = (bf16*)(ws + WS_OW); bf16* W_QKVB = (bf16*)(ws + WS_QKVB); bf16* W_QKVA = (bf16*)(ws + WS_QKVA);
    bf16* W_S5ST = (bf16*)(ws + WS_S5ST); bf16* W_S5W3 = (bf16*)(ws + WS_S5W3);
    float* ROPE_C = (float*)(ws + WS_ROPE); float* ROPE_S = ROPE_C + SEQ * 32;
    float* PTAB = (float*)(ws + WS_PTAB); float* BBTAB = (float*)(ws + WS_BBTAB);
    bf16* A3 = (bf16*)(ws + WS_A3); float* SEND = (float*)(ws + WS_SEND); bf16* ACT = (bf16*)(ws + WS_ACT); bf16* Hb = (bf16*)(ws + WS_H);
    bf16* X1 = (bf16*)(ws + WS_X1); bf16* FFNH = (bf16*)(ws + WS_FFNH); bf16* X2 = (bf16*)(ws + WS_X2); float* QKVAF = (float*)(ws + WS_QKVAF);
    bf16* CQKV = (bf16*)(ws + WS_CQKV); bf16* KROPE = (bf16*)(ws + WS_KROPE); bf16* QKV = (bf16*)(ws + WS_QKV); bf16* H3b = (bf16*)(ws + WS_H3);
    bf16* OB = (bf16*)(ws + WS_O); bf16* X3 = (bf16*)(ws + WS_X3); bf16* MOEH = (bf16*)(ws + WS_MOEH); fp8* X3Q = (fp8*)(ws + WS_MOEH + 232 * MiB); (void)X3Q; float* YSLAB = (float*)(ws + WS_MOEH + 264 * MiB); (void)YSLAB;   bf16* YB = (bf16*)(ws + WS_Y);
    int* ROW_TOK = (int*)(ws + WS_ROUTE); int* TOK_INFO = (int*)(ws + WS_ROUTE + 1 * MiB); float* GATES = (float*)(ws + WS_ROUTE + 1 * MiB + 512 * 1024);

    if (IN(0) || IN(18) || IN(19) || IN(20)) {
        PHASE_IDS();
        LAS float* scr = (LAS float*)(lds + RING_OFF + wave * 16640);
        constexpr int I_GLU = 16 * 32, I_FIN = 16 * 88, I_FOUT = (FFN_DOWN_FP8 ? 22 : 44) * 16, I_QA = 16 * 4, I_KVA = 16 * 3, I_O = MLA_ABSORB ? 0 : 16 * 16, I_QB = MLA_ABSORB ? 0 : 4 * 24, I_KVB = MLA_ABSORB ? 0 : 2 * 32, I_MIN = (MOE_FP8 ? (CONV_IN_ATTN ? 0 : 8) : 16) * 112, I_MOUT = (MOE_FP8 ? 28 : 56) * 16;
        constexpr int NITEMS = I_GLU + I_FIN + I_FOUT + I_QA + I_KVA + I_O + I_QB + I_KVB + NEXP * (I_MIN + (MOE_FP8 ? 0 : I_MOUT));
        if (IN(0) || IN(18))
        for (int it = gw; it < NITEMS; it += NGW) {
            int r = it;
            if (r < I_GLU) { tr_matrix_item(args.in[I_WGLU], D, 2 * D, W_GLU, D, 0, 0, D, scr, r, lane); continue; } r -= I_GLU;
            if (r < I_FIN) { tr_matrix_item(args.in[I_FFNIN], D, 2 * FFN, W_FFNIN, D, 0, 0, FFN, scr, r, lane); continue; } r -= I_FIN;
#if FFN_DOWN_FP8
            if (r < I_FOUT) { tr_matrix_item8(args.in[I_FFNOUT], D, (fp8*)W_FFNOUT, FFN, 0, MOE_SC_OUT, scr, r, lane); continue; } r -= I_FOUT;
#else
            if (r < I_FOUT) { tr_matrix_item(args.in[I_FFNOUT], FFN, D, W_FFNOUT, FFN, 0, 0, 0, scr, r, lane); continue; } r -= I_FOUT;
#endif
            if (r < I_QA) { tr_matrix_item(args.in[I_QWA], D, QL, W_QKVA, D, 0, 0, 0, scr, r, lane); continue; } r -= I_QA;
            if (r < I_KVA) { tr_matrix_item(args.in[I_KVWA], D, KVL + QKR, W_QKVA, D, QL, 0, 0, scr, r, lane); continue; } r -= I_KVA;
#if !MLA_ABSORB
            if (r < I_O) { tr_matrix_item(args.in[I_OW], D, D, W_OW, D, 0, 0, 0, scr, r, lane); continue; } r -= I_O;
            if (r < I_QB) { tr_matrix_item(args.in[I_QWB], QL, QW, W_QKVB, QKVB_K, 0, 0, 0, scr, r, lane); continue; } r -= I_QB;
            if (r < I_KVB) { tr_matrix_item(args.in[I_KVWB], KVL, HEADS * (QKN + VD), W_QKVB, QKVB_K, QW, QL, 0, scr, r, lane); continue; } r -= I_KVB;
#endif
#if MOE_FP8 && CONV_IN_ATTN
            (void)r;
#elif MOE_FP8
            { const int e = r / I_MIN; tr_matrix_item8(args.in[I_MOEIN] + (size_t)e * D * 2 * EXD, 2 * EXD, (fp8*)W_MOEIN + (size_t)e * 2 * EXD * D, D, EXD, MOE_SC_IN, scr, r % I_MIN, lane); }
#else
            if (r < NEXP * I_MIN) { const int e = r / I_MIN; tr_matrix_item(args.in[I_MOEIN] + (size_t)e * D * 2 * EXD, D, 2 * EXD, W_MOEIN + (size_t)e * 2 * EXD * D, D, 0, 0, EXD, scr, r % I_MIN, lane); continue; } r -= NEXP * I_MIN;
            { const int e = r / I_MOUT; tr_matrix_item(args.in[I_MOEOUT] + (size_t)e * EXD * D, EXD, D, W_MOEOUT + (size_t)e * D * EXD, EXD, 0, 0, 0, scr, r % I_MOUT, lane); }
#endif
        }
        if (IN(0) || IN(19)) { const u32x4 z = {0u, 0u, 0u, 0u}; const size_t gt = (size_t)gw * 64 + lane, GT = (size_t)NGW * 64;
          for (size_t i = gt; i < (size_t)64 * D / 8; i += GT) *(GAS u32x4*)(W_QKVA + (size_t)448 * D + i * 8) = z;
#if !MLA_ABSORB
          for (size_t i = gt; i < (size_t)QW * 16; i += GT) { const size_t row = i / 16, ch = i % 16; *(GAS u32x4*)(W_QKVB + row * QKVB_K + QL + ch * 8) = z; }
          for (size_t i = gt; i < (size_t)2048 * 32; i += GT) { const size_t row = i / 32, ch = i % 32; *(GAS u32x4*)(W_QKVB + (QW + row) * QKVB_K + ch * 8) = z; }
#endif
          for (size_t i = gt; i < (size_t)S5G * 128 * 32; i += GT) { const size_t g = i / (128 * 32), rem = i % (128 * 32); *(GAS u32x4*)(W_S5ST + (g * 256 + 128) * 256 + rem * 8) = z; } }
        if (IN(0) || IN(19))
        for (int i = gw * 64 + lane; i < SEQ * 32; i += NGW * 64) { const int pos = i >> 5, f = i & 31; const float inv = powf(10000.0f, -(float)(2 * f) / 64.0f); const float ang = (float)pos * inv; float s, c; sincosf(ang, &s, &c); ROPE_C[i] = c; ROPE_S[i] = s; }
        if (IN(0) || IN(19))
        for (int i = gw * 64 + lane; i < S5G * S5P * 16; i += NGW * 64) {
            const int k = i & 15, gn = i >> 4, g = gn >> 6, n = gn & 63;
            const float lr = args.in[I_LAMRE][gn], li = args.in[I_LAMIM][gn], dt = expf(args.in[I_LOGSTEP][g]);
            const float mag = expf(lr * dt); float sn, cs; sincosf(li * dt, &sn, &cs); const float lbr = mag * cs, lbi = mag * sn;
            const float den = lr * lr + li * li, fre = ((lbr - 1.0f) * lr + lbi * li) / den, fim = (lbi * lr - (lbr - 1.0f) * li) / den;
            float pr = 1.f, pi = 0.f, pkr = 1.f, pki = 0.f, pwr = 1.f, pwi = 0.f;
#pragma unroll
            for (int d = 1; d <= 16; ++d) { const float nr = pr * lbr - pi * lbi, ni = pr * lbi + pi * lbr; pr = nr; pi = ni; if (d == k) { pkr = pr; pki = pi; } if (d == 15 - k) { pwr = pr; pwi = pi; } }
            *(GAS f32x2*)(PTAB + ((size_t)gn * 17 + k) * 2) = (f32x2){pkr, pki};
            if (k == 15) *(GAS f32x2*)(PTAB + ((size_t)gn * 17 + 16) * 2) = (f32x2){pr, pi};
            const float* brp = args.in[I_BRE] + (size_t)gn * 16; const float* bip = args.in[I_BIM] + (size_t)gn * 16;
            float bbr[16], bbi[16];
#pragma unroll
            for (int q = 0; q < 4; ++q) { const f32x4 br = *(const GAS f32x4*)(brp + 4 * q), bi = *(const GAS f32x4*)(bip + 4 * q);
#pragma unroll
                for (int e = 0; e < 4; ++e) { bbr[4 * q + e] = fre * br[e] - fim * bi[e]; bbi[4 * q + e] = fre * bi[e] + fim * br[e]; } }
            { float mr = 0.f, mi = 0.f;
#pragma unroll
              for (int ch = 0; ch < 16; ++ch) { mr = (ch == k) ? bbr[ch] : mr; mi = (ch == k) ? bbi[ch] : mi; }
              *(GAS f32x2*)(BBTAB + ((size_t)gn * 16 + k) * 2) = (f32x2){mr, mi}; }
            bf16* wre = W_S5ST + ((size_t)g * 256 + n) * 256 + k * 16; bf16* wim = W_S5ST + ((size_t)g * 256 + 64 + n) * 256 + k * 16;
            u32x4 a0, a1, b0, b1;
#pragma unroll
            for (int e = 0; e < 4; ++e) { const int c0 = 2 * e, c1 = 2 * e + 1;
                a0[e] = cvt_pk_bf16(pwr * bbr[c0] - pwi * bbi[c0], pwr * bbr[c1] - pwi * bbi[c1]); a1[e] = cvt_pk_bf16(pwr * bbr[8 + c0] - pwi * bbi[8 + c0], pwr * bbr[8 + c1] - pwi * bbi[8 + c1]);
                b0[e] = cvt_pk_bf16(pwr * bbi[c0] + pwi * bbr[c0], pwr * bbi[c1] + pwi * bbr[c1]); b1[e] = cvt_pk_bf16(pwr * bbi[8 + c0] + pwi * bbr[8 + c0], pwr * bbi[8 + c1] + pwi * bbr[8 + c1]); }
            *(GAS u32x4*)(wre) = a0; *(GAS u32x4*)(wre + 8) = a1; *(GAS u32x4*)(wim) = b0; *(GAS u32x4*)(wim + 8) = b1;
        }
        __syncthreads();
        if (IN(0) || IN(20)) {
            LAS unsigned char* tile = lds + RING_OFF;
            f32x4 v[2][4];
#define A3_LOAD(bc_) do { _Pragma("unroll") for (int t = 0; t < 2; ++t) _Pragma("unroll") for (int q = 0; q < 4; ++q) v[t][q] = __builtin_nontemporal_load((const GAS f32x4*)(x_in + ((size_t)(bc_) * LCH + 2 * wave + t) * D + q * 256 + 4 * lane)); } while (0)
            int bc = vcu;
            if (bc < NBC) A3_LOAD(bc);
            for (; bc < NBC; bc += G) {
#pragma unroll
                for (int t = 0; t < 2; ++t)
#pragma unroll
                    for (int q = 0; q < 4; ++q) { u32x2 w; w.x = cvt_pk_bf16(v[t][q][0], v[t][q][1]); w.y = cvt_pk_bf16(v[t][q][2], v[t][q][3]); *(LAS u32x2*)(tile + (2 * wave + t) * 2080 + (q * 256 + 4 * lane) * 2) = w; }
                if (bc + G < NBC) A3_LOAD(bc + G);
                LDS_WAIT(); __builtin_amdgcn_s_barrier(); asm volatile("" ::: "memory");
                const int t32 = lane & 31, j = t32 >> 1, half = t32 & 1;
#pragma unroll
                for (int i2 = 0; i2 < 4; ++i2) { const int g = 8 * wave + 2 * i2 + (lane >> 5); const u32x4 w = *(const LAS u32x4*)(tile + j * 2080 + g * 32 + half * 16);
                    __builtin_nontemporal_store(w, (GAS u32x4*)(A3 + ((size_t)g * NBC + bc) * A3_LD + j * 16 + half * 8)); }
                LDS_WAIT(); __builtin_amdgcn_s_barrier(); asm volatile("" ::: "memory");
            }
#undef A3_LOAD
        }
        if (BOTH(0)) GRID_BAR();
    }

    if (IN(1)) {
        pg8::GroupSched S{(const char*)A3, (const char*)W_S5ST, G, bx, (size_t)NBC * A3_LD * 2, (size_t)256 * 256 * 2, (size_t)256 * A3_LD * 2, 4};
        pg8::EpiS1 E{SEND};
        pg8::gemm_phase<pg8::EpiS1, pg8::GroupSched, false>(lds + RING_OFF, 256 * 2, A3_LD * 2, S, E);
        if (BOTH(1)) GRID_BAR();
    }

    if (IN(2) || IN(21) || IN(22) || IN(23) || IN(24)) {
        PHASE_IDS();
#if MLA_ABSORB
        if (IN(2) || IN(21))
        { LAS float* TA = (LAS float*)(lds + RING_OFF); LAS float* TB = TA + 128 * 132;
          for (int it2 = vcu; it2 < 160; it2 += G) {
              const int it = it2 >> 1, half = it2 & 1;
              const bool tq = it < 16; const int h = tq ? (it >> 1) : ((it - 16) >> 3), sb = tq ? (it & 1) : ((it - 16) & 7);
              const float* srcI = tq ? args.in[I_QWB] + (size_t)(sb * 128) * QW + h * (QKN + QKR) : args.in[I_KVWB] + h * (QKN + VD) + QKN; const int pI = tq ? QW : HEADS * (QKN + VD);
#pragma unroll
              for (int q = 0; q < 8; ++q) { const int idx = tid + 512 * q, row = idx >> 5, c4 = (idx & 31) * 4; *(LAS f32x4*)(TA + row * 132 + c4) = *(const GAS f32x4*)(srcI + (size_t)row * pI + c4); }
              if (tq) { const float* srcN = args.in[I_KVWB] + (size_t)(half * 64) * (HEADS * (QKN + VD)) + h * (QKN + VD);
#pragma unroll
                  for (int q = 0; q < 4; ++q) { const int idx = tid + 512 * q, row = idx >> 5, c4 = (idx & 31) * 4; *(LAS f32x4*)(TB + row * 132 + c4) = *(const GAS f32x4*)(srcN + (size_t)row * (HEADS * (QKN + VD)) + c4); }
              } else { const float* srcN = args.in[I_OW] + (size_t)(h * VD) * D + sb * 128 + half * 64;
#pragma unroll
                  for (int q = 0; q < 4; ++q) { const int idx = tid + 512 * q, dr = idx >> 4, n4 = (idx & 15) * 4; const f32x4 v = *(const GAS f32x4*)(srcN + (size_t)dr * D + n4);
                      TB[(n4 + 0) * 132 + dr] = v[0]; TB[(n4 + 1) * 132 + dr] = v[1]; TB[(n4 + 2) * 132 + dr] = v[2]; TB[(n4 + 3) * 132 + dr] = v[3]; } }
              LDS_WAIT(); __syncthreads();
              const int r32 = lane & 31, hi = lane >> 5, iblk = wave & 3, nblk = wave >> 2;
              const LAS float* pa = TA + (iblk * 32 + r32) * 132 + 4 * hi; const LAS float* pb = TB + (nblk * 32 + r32) * 132 + 4 * hi;
              f32x16 acc = {};
#pragma unroll 4
              for (int m = 0; m < 16; ++m) { const f32x4 av = *(const LAS f32x4*)(pa + 8 * m), bv = *(const LAS f32x4*)(pb + 8 * m);
#pragma unroll
                  for (int e = 0; e < 4; ++e) acc = __builtin_amdgcn_mfma_f32_32x32x2f32(av[e], bv[e], acc, 0, 0, 0); }
              { const int ng = half * 64 + nblk * 32 + r32;
                bf16* orow = tq ? W_QKVB + (size_t)(h * (QKN + QKR) + ng) * QL + sb * 128 : W_OW + (size_t)(sb * 128 + ng) * D + h * VD;
#pragma unroll
                for (int rq = 0; rq < 4; ++rq) { u32x2 w; w.x = cvt_pk_bf16(acc[4 * rq], acc[4 * rq + 1]); w.y = cvt_pk_bf16(acc[4 * rq + 2], acc[4 * rq + 3]);
                    *(GAS u32x2*)(orow + iblk * 32 + 8 * rq + 4 * hi) = w; } }
              LDS_WAIT(); __syncthreads();
          }
          { LAS float* scr = (LAS float*)(lds + RING_OFF + wave * 16640);
            for (int it = gw; it < HEADS * 4; it += NGW) { const int h = it >> 2, kb = it & 3; tr_item(args.in[I_QWB], QW, W_QKVB, QL, kb * 64, h * (QKN + QKR) + QKN, h * (QKN + QKR) + QKN, 0, scr, lane); } }
          __syncthreads();
        }
#endif
        if (IN(2) || IN(22)) {
        { LAS float* LC = (LAS float*)(lds + RING_OFF);
          LAS float* LP = LC + 2 * 16 * 65 + 16;
          LAS float* LB = LP + 2176;
          for (int it = vcu; it < S5G * 4; it += G) {
              const int g = it >> 2, dq = it & 3;
              { const int half = tid >> 8, t = tid & 255, co_ = t >> 4, c4 = (t & 15) * 4; const f32x4 v = *(const GAS f32x4*)(args.in[half ? I_CIM : I_CRE] + (size_t)g * 1024 + t * 4);
                LAS float* dst = LC + half * (16 * 65) + co_ * 65 + c4; dst[0] = v[0]; dst[1] = v[1]; dst[2] = v[2]; dst[3] = v[3]; }
              for (int i = tid; i < 544; i += 512) *(LAS f32x4*)(LP + i * 4) = *(const GAS f32x4*)(PTAB + (size_t)g * 2176 + i * 4);
              *(LAS f32x4*)(LB + tid * 4) = *(const GAS f32x4*)(BBTAB + (size_t)g * 2048 + tid * 4);
              LDS_WAIT(); __syncthreads();
              { const int sub = tid & 3, cih = (tid >> 2) & 1, co = (tid >> 3) & 15, d = dq * 4 + (tid >> 7);
                float acc8[8];
#pragma unroll
                for (int e = 0; e < 8; ++e) acc8[e] = 0.f;
                for (int n = sub; n < 64; n += 4) {
                    const f32x2 p = *(const LAS f32x2*)(LP + (n * 17 + d) * 2);
                    const float cr = LC[co * 65 + n], ci = LC[16 * 65 + co * 65 + n], cpr = cr * p.x - ci * p.y, cpi = cr * p.y + ci * p.x;
                    const LAS float* bb = LB + (n * 16 + cih * 8) * 2;
                    const f32x4 b0 = *(const LAS f32x4*)(bb), b1 = *(const LAS f32x4*)(bb + 4), b2 = *(const LAS f32x4*)(bb + 8), b3 = *(const LAS f32x4*)(bb + 12);
                    acc8[0] += cpr * b0[0] - cpi * b0[1]; acc8[1] += cpr * b0[2] - cpi * b0[3]; acc8[2] += cpr * b1[0] - cpi * b1[1]; acc8[3] += cpr * b1[2] - cpi * b1[3];
                    acc8[4] += cpr * b2[0] - cpi * b2[1]; acc8[5] += cpr * b2[2] - cpi * b2[3]; acc8[6] += cpr * b3[0] - cpi * b3[1]; acc8[7] += cpr * b3[2] - cpi * b3[3];
                }
#pragma unroll
                for (int e = 0; e < 8; ++e) { acc8[e] += __shfl_xor(acc8[e], 1); acc8[e] += __shfl_xor(acc8[e], 2); }
                if (sub == 0) {
                    if (d == 0) { const float ds = args.in[I_SD][g * 16 + co];
#pragma unroll
                        for (int e = 0; e < 8; ++e) if (cih * 8 + e == co) acc8[e] += ds; }
                    u32x4 w; w.x = cvt_pk_bf16(acc8[0], acc8[1]); w.y = cvt_pk_bf16(acc8[2], acc8[3]); w.z = cvt_pk_bf16(acc8[4], acc8[5]); w.w = cvt_pk_bf16(acc8[6], acc8[7]);
                    const u32x4 z = {0u, 0u, 0u, 0u};
                    bf16* base = W_S5W3 + (size_t)g * 256 * A3_LD + cih * 8;
                    for (int k = 0; k + d < 16; ++k) { const int j = k + d; *(GAS u32x4*)(base + (size_t)(j * 16 + co) * A3_LD + k * 16) = w; if (d > 0) *(GAS u32x4*)(base + (size_t)(k * 16 + co) * A3_LD + j * 16) = z; }
                } }
              { const int no = tid & 7, co = (tid >> 3) & 15, j = dq * 4 + (tid >> 7), row = j * 16 + co;
                float vr[8], vi[8];
#pragma unroll
                for (int e = 0; e < 8; ++e) { const int n = no * 8 + e; const f32x2 p = *(const LAS f32x2*)(LP + (n * 17 + j + 1) * 2);
                    const float cr = LC[co * 65 + n], ci = LC[16 * 65 + co * 65 + n]; vr[e] = cr * p.x - ci * p.y; vi[e] = -(cr * p.y + ci * p.x); }
                u32x4 a, b; a.x = cvt_pk_bf16(vr[0], vr[1]); a.y = cvt_pk_bf16(vr[2], vr[3]); a.z = cvt_pk_bf16(vr[4], vr[5]); a.w = cvt_pk_bf16(vr[6], vr[7]);
                b.x = cvt_pk_bf16(vi[0], vi[1]); b.y = cvt_pk_bf16(vi[2], vi[3]); b.z = cvt_pk_bf16(vi[4], vi[5]); b.w = cvt_pk_bf16(vi[6], vi[7]);
                bf16* rp = W_S5W3 + ((size_t)g * 256 + row) * A3_LD + 256 + no * 8;
                *(GAS u32x4*)(rp) = a; *(GAS u32x4*)(rp + 64) = b; }
              LDS_WAIT(); __syncthreads();
          } }
        }
        if (IN(2) || IN(23) || IN(24)) {
#if MOE_FP8
        if (wave >= 4) {
            LAS float* scr = (LAS float*)(lds + RING_OFF + wave * 16640);
            constexpr int I_MOUT2 = 28 * 16;
            if (!IN(24))
            for (int it = vcu * 4 + (wave - 4); it < NEXP * I_MOUT2; it += G * 4) { const int e = it / I_MOUT2;
                tr_matrix_item8(args.in[I_MOEOUT] + (size_t)e * EXD * D, D, (fp8*)W_MOEOUT + (size_t)e * D * EXD, EXD, 0, MOE_SC_OUT, scr, it % I_MOUT2, lane); }
        } else
        for (int chain = vcu * 4 + wave; chain < S5G * BATCH; chain += G * 4) {
#else
        for (int chain = gw; chain < S5G * BATCH; chain += NGW) {
#endif
            const int g = chain >> 4, b = chain & 15;
            const f32x2 p16 = *(const GAS f32x2*)(PTAB + (((size_t)g * 64 + lane) * 17 + 16) * 2);
            const float* sp = SEND + ((size_t)g * NBC + b * NCHUNK) * 128 + lane; bf16* ap = A3 + ((size_t)g * NBC + b * NCHUNK) * A3_LD + 256 + lane;
            float sr_ = 0.f, si_ = 0.f;
            float er[8], ei[8], fr_[8], fi_[8];
#pragma unroll
            for (int q = 0; q < 8; ++q) { er[q] = sp[(size_t)q * 128]; ei[q] = sp[(size_t)q * 128 + 64]; }
            for (int c0 = 0; c0 < NCHUNK; c0 += 8) {
                const int cn = (c0 + 8 < NCHUNK) ? c0 + 8 : c0;
#pragma unroll
                for (int q = 0; q < 8; ++q) { fr_[q] = sp[(size_t)(cn + q) * 128]; fi_[q] = sp[(size_t)(cn + q) * 128 + 64]; }
#pragma unroll
                for (int q = 0; q < 8; ++q) { ap[(size_t)(c0 + q) * A3_LD] = (bf16)(cvt_pk_bf16(sr_, 0.f) & 0xffffu); ap[(size_t)(c0 + q) * A3_LD + 64] = (bf16)(cvt_pk_bf16(si_, 0.f) & 0xffffu);
                    const float nr = p16.x * sr_ - p16.y * si_ + er[q], ni = p16.x * si_ + p16.y * sr_ + ei[q]; sr_ = nr; si_ = ni; }
#pragma unroll
                for (int q = 0; q < 8; ++q) { er[q] = fr_[q]; ei[q] = fi_[q]; }
            }
        }
        }
        if (BOTH(2)) GRID_BAR();
    }

    if (IN(3)) {
        pg8::GroupSched S{(const char*)A3, (const char*)W_S5W3, G, bx, (size_t)NBC * A3_LD * 2, (size_t)256 * A3_LD * 2, (size_t)256 * A3_LD * 2, 6};
        pg8::EpiS3 E{ACT};
        pg8::gemm_phase<pg8::EpiS3, pg8::GroupSched, false>(lds + RING_OFF, A3_LD * 2, A3_LD * 2, S, E);
        if (BOTH(3)) GRID_BAR();
    }

    if (IN(4)) {
        pg8::DenseSched S{(const char*)ACT, (const char*)W_GLU, NTOK / 256, 2 * D / 256, G, bx, (size_t)256 * D * 2, (size_t)256 * D * 2, D / 64};
        pg8::EpiGLU E{Hb};
        pg8::gemm_phase<pg8::EpiGLU, pg8::DenseSched, false>(lds + RING_OFF, D * 2, D * 2, S, E);
        if (BOTH(4)) GRID_BAR();
    }
#define LN_ROW_STATS(v, mean, rstd) do { float s_ = 0.f; _Pragma("unroll") for (int j = 0; j < 4; ++j) s_ += (v[j][0] + v[j][1]) + (v[j][2] + v[j][3]); mean = wave_sum(s_) * (1.f / D); float s2_ = 0.f; \
        _Pragma("unroll") for (int j = 0; j < 4; ++j) { v[j] = v[j] - mean; s2_ += (v[j][0] * v[j][0] + v[j][1] * v[j][1]) + (v[j][2] * v[j][2] + v[j][3] * v[j][3]); } rstd = 1.f / sqrtf(wave_sum(s2_) * (1.f / D) + LN_EPS); } while (0)
#define LN_LOAD_F32RES(v, RES, BR, m) do { const GAS f32x4* xr_ = (const GAS f32x4*)((RES) + (size_t)(m) * D) + lane; const GAS u32x2* br_ = (const GAS u32x2*)((BR) + (size_t)(m) * D) + lane; \
        _Pragma("unroll") for (int j = 0; j < 4; ++j) { const f32x4 xa = __builtin_nontemporal_load(xr_ + 64 * j); const u32x2 ba = br_[64 * j]; \
            v[j][0] = ALPHA * xa[0] + bf_lo(ba.x); v[j][1] = ALPHA * xa[1] + bf_hi(ba.x); v[j][2] = ALPHA * xa[2] + bf_lo(ba.y); v[j][3] = ALPHA * xa[3] + bf_hi(ba.y); } } while (0)
#define LN_LOAD_BF16RES(v, RES, BR, m) do { const GAS u32x2* xr_ = (const GAS u32x2*)((RES) + (size_t)(m) * D) + lane; const GAS u32x2* br_ = (const GAS u32x2*)((BR) + (size_t)(m) * D) + lane; \
        _Pragma("unroll") for (int j = 0; j < 4; ++j) { const u32x2 xa = xr_[64 * j]; const u32x2 ba = br_[64 * j]; \
            v[j][0] = ALPHA * bf_lo(xa.x) + bf_lo(ba.x); v[j][1] = ALPHA * bf_hi(xa.x) + bf_hi(ba.x); v[j][2] = ALPHA * bf_lo(xa.y) + bf_lo(ba.y); v[j][3] = ALPHA * bf_hi(xa.y) + bf_hi(ba.y); } } while (0)
#define LN_STORE_BF16(v, rstd, DST, m) do { GAS u32x2* o8 = (GAS u32x2*)((DST) + (size_t)(m) * D) + lane; \
        _Pragma("unroll") for (int j = 0; j < 4; ++j) { const f32x4 y = v[j] * rstd * gv[j] + bv[j]; u32x2 w; w.x = cvt_pk_bf16(y[0], y[1]); w.y = cvt_pk_bf16(y[2], y[3]); o8[64 * j] = w; } } while (0)
#define LN_PHASE(LOADER, RES, BR, DST, LIDX) do { const float* gp = args.in[I_LNG] + (LIDX) * D + lane * 4; const float* bp = args.in[I_LNB] + (LIDX) * D + lane * 4; f32x4 gv[4], bv[4]; \
        _Pragma("unroll") for (int j = 0; j < 4; ++j) { gv[j] = *(const GAS f32x4*)(gp + 256 * j); bv[j] = *(const GAS f32x4*)(bp + 256 * j); } \
        for (int m = gw; m < NTOK; m += 2 * NGW) { const int m2 = m + NGW; const bool two = m2 < NTOK; f32x4 va[4], vb[4]; LOADER(va, RES, BR, m); LOADER(vb, RES, BR, (two ? m2 : m)); \
            float mean_a, rstd_a, mean_b, rstd_b; LN_ROW_STATS(va, mean_a, rstd_a); LN_ROW_STATS(vb, mean_b, rstd_b); \
            LN_STORE_BF16(va, rstd_a, DST, m); if (two) LN_STORE_BF16(vb, rstd_b, DST, m2); } } while (0)
    if (IN(5)) { PHASE_IDS(); LN_PHASE(LN_LOAD_F32RES, x_in, Hb, X1, 0); if (BOTH(5)) GRID_BAR(); }

    if (IN(6)) {
        pg8::DenseSched S{(const char*)X1, (const char*)W_FFNIN, NTOK / 256, 2 * FFN / 256, G, bx, (size_t)256 * D * 2, (size_t)256 * D * 2, D / 64};
#if FFN_DOWN_FP8
        pg8::EpiSwiGLU8 E{(fp8*)FFNH, FFN, 1.0f};
        pg8::gemm_phase<pg8::EpiSwiGLU8, pg8::DenseSched, false>(lds + RING_OFF, D * 2, D * 2, S, E);
#else
        pg8::EpiSwiGLU E{FFNH, FFN};
        pg8::gemm_phase<pg8::EpiSwiGLU, pg8::DenseSched, false>(lds + RING_OFF, D * 2, D * 2, S, E);
#endif
        if (BOTH(6)) GRID_BAR();
    }
    if (IN(7)) {
#if FFN_DOWN_FP8
        pg8::DenseSched S{(const char*)FFNH, (const char*)W_FFNOUT, NTOK / 256, D / 256, G, bx, (size_t)256 * FFN, (size_t)256 * FFN, FFN / 128};
        pg8::EpiBf16S E{Hb, D, 1.0f / MOE_SC_OUT};
        pg8::gemm_phase<pg8::EpiBf16S, pg8::DenseSched, false, true>(lds + RING_OFF, FFN, FFN, S, E);
#else
        pg8::DenseSched S{(const char*)FFNH, (const char*)W_FFNOUT, NTOK / 256, D / 256, G, bx, (size_t)256 * FFN * 2, (size_t)256 * FFN * 2, FFN / 64};
        pg8::EpiBf16 E{Hb, D};
        pg8::gemm_phase<pg8::EpiBf16, pg8::DenseSched, false>(lds + RING_OFF, FFN * 2, FFN * 2, S, E);
#endif
        if (BOTH(7)) GRID_BAR();
    }
    if (IN(8)) { PHASE_IDS(); LN_PHASE(LN_LOAD_BF16RES, X1, Hb, X2, 1); if (BOTH(8)) GRID_BAR(); }

    if (IN(9)) {
        pg8::DenseSched S{(const char*)X2, (const char*)W_QKVA, NTOK / 256, QKVA_N / 256, G, bx, (size_t)256 * D * 2, (size_t)256 * D * 2, D / 64};
        if (G == (NTOK / 256) * (QKVA_N / 256)) {
            pg8::EpiQkvaPrep E{CQKV, KROPE, args.in[I_QNORM], args.in[I_KVNORM], ROPE_C, ROPE_S};
            pg8::gemm_phase<pg8::EpiQkvaPrep, pg8::DenseSched, false>(lds + RING_OFF, D * 2, D * 2, S, E);
        } else {
        pg8::EpiF32 E{QKVAF, QKVA_N};
        pg8::gemm_phase<pg8::EpiF32, pg8::DenseSched, false>(lds + RING_OFF, D * 2, D * 2, S, E);
        }
        if (BOTH(9)) GRID_BAR();
    }
    if (IN(10) && G != (NTOK / 256) * (QKVA_N / 256)) {
        PHASE_IDS();
        f32x4 g0 = {0.f, 0.f, 0.f, 0.f}, g1 = {0.f, 0.f, 0.f, 0.f};
        if (lane < 32) { g0 = *(const GAS f32x4*)(args.in[I_QNORM] + lane * 8); g1 = *(const GAS f32x4*)(args.in[I_QNORM] + lane * 8 + 4); }
        else if (lane < 48) { g0 = *(const GAS f32x4*)(args.in[I_KVNORM] + (lane - 32) * 8); g1 = *(const GAS f32x4*)(args.in[I_KVNORM] + (lane - 32) * 8 + 4); }
        for (int m = gw; m < NTOK; m += NGW) {
            const float* rp = QKVAF + (size_t)m * QKVA_N + lane * 8; const f32x4 a0 = *(const GAS f32x4*)(rp), a1 = *(const GAS f32x4*)(rp + 4);
            const float ss = (a0[0] * a0[0] + a0[1] * a0[1]) + (a0[2] * a0[2] + a0[3] * a0[3]) + (a1[0] * a1[0] + a1[1] * a1[1]) + (a1[2] * a1[2] + a1[3] * a1[3]);
            const float sq = wave_sum(lane < 32 ? ss : 0.f), skv = wave_sum((lane >= 32 && lane < 48) ? ss : 0.f);
            const float rq = 1.f / sqrtf(sq * (1.f / QL) + RMS_EPS), rkv = 1.f / sqrtf(skv * (1.f / KVL) + RMS_EPS);
            const int partner = (lane >= 48 && lane < 52) ? lane + 4 : ((lane >= 52 && lane < 56) ? lane - 4 : lane);
            f32x4 p0, p1;
#pragma unroll
            for (int e = 0; e < 4; ++e) { p0[e] = __shfl(a0[e], partner); p1[e] = __shfl(a1[e], partner); }
            if (lane < 48) { const float rs = lane < 32 ? rq : rkv; u32x4 w; w.x = cvt_pk_bf16(a0[0] * rs * g0[0], a0[1] * rs * g0[1]); w.y = cvt_pk_bf16(a0[2] * rs * g0[2], a0[3] * rs * g0[3]);
                w.z = cvt_pk_bf16(a1[0] * rs * g1[0], a1[1] * rs * g1[1]); w.w = cvt_pk_bf16(a1[2] * rs * g1[2], a1[3] * rs * g1[3]); *(GAS u32x4*)(CQKV + (size_t)m * QKVB_K + lane * 8) = w; }
            else if (lane < 56) { const int pos = m & (SEQ - 1), fi = ((lane - 48) & 3) * 8; const float* cp = ROPE_C + pos * 32 + fi; const float* sp = ROPE_S + pos * 32 + fi;
                const f32x4 c0 = *(const GAS f32x4*)(cp), c1 = *(const GAS f32x4*)(cp + 4), s0 = *(const GAS f32x4*)(sp), s1 = *(const GAS f32x4*)(sp + 4); f32x4 o0, o1;
                if (lane < 52) { o0 = a0 * c0 - p0 * s0; o1 = a1 * c1 - p1 * s1; }
                else { o0 = p0 * s0 + a0 * c0; o1 = p1 * s1 + a1 * c1; }
                u32x4 w; w.x = cvt_pk_bf16(o0[0], o0[1]); w.y = cvt_pk_bf16(o0[2], o0[3]); w.z = cvt_pk_bf16(o1[0], o1[1]); w.w = cvt_pk_bf16(o1[2], o1[3]);
                *(GAS u32x4*)(KROPE + (size_t)m * 64 + (lane - 48) * 8) = w; }
        }
        if (BOTH(10)) GRID_BAR();
    }
    if (IN(11)) {
#if MLA_ABSORB
        pg8::DenseSched S{(const char*)CQKV, (const char*)W_QKVB, NTOK / 256, QW / 256, G, bx, (size_t)256 * QKVB_K * 2, (size_t)256 * QL * 2, QL / 64};
        pg8::EpiBf16 E{QKV, QW};
        pg8::gemm_phase<pg8::EpiBf16, pg8::DenseSched, false>(lds + RING_OFF, QL * 2, QKVB_K * 2, S, E);
#else
        pg8::QkvbSched S{(const char*)CQKV, (const char*)W_QKVB, G, bx};
        pg8::EpiBf16 E{QKV, QKVB_N};
        pg8::gemm_phase<pg8::EpiBf16, pg8::QkvbSched, false>(lds + RING_OFF, QKVB_K * 2, QKVB_K * 2, S, E);
#endif
        if (BOTH(11)) GRID_BAR();
    }
    if (IN(12)) {
        att::Conv cv{args.in[I_MOEIN], (unsigned char*)W_MOEIN, 0, G, bx, 0, 0};
        for (int it = vcu; it < BATCH * HEADS * 4; it += G) {
            const int bh = it >> 2, xq = it & 3, b = bh >> 3, h = bh & 7;
            for (int pass = 0; pass < 2; ++pass) { const int qb = pass ? 7 - xq : xq; const size_t tok0 = (size_t)b * SEQ;
#if MLA_ABSORB
                att::attn_block<QW, QKVB_K>(QKV + (tok0 + qb * 256) * QW + h * (QKN + QKR), CQKV + tok0 * QKVB_K + QL, CQKV + tok0 * QKVB_K + QL,
                                KROPE + tok0 * 64, OB + (tok0 + qb * 256) * D + h * VD, qb * 256, ROPE_C, ROPE_S, (char*)lds_raw + RING_OFF, lds + RING_OFF, cv); }
#else
                att::attn_block<QKVB_N, QKVB_N>(QKV + (tok0 + qb * 256) * QKVB_N + h * (QKN + QKR), QKV + tok0 * QKVB_N + QW + h * (QKN + VD), QKV + tok0 * QKVB_N + QW + h * (QKN + VD) + QKN,
                                KROPE + tok0 * 64, OB + (tok0 + qb * 256) * D + h * VD, qb * 256, ROPE_C, ROPE_S, (char*)lds_raw + RING_OFF, lds + RING_OFF, cv); }
#endif
        }
        if (CONV_IN_ATTN) att::conv_drain(cv, lds + RING_OFF);
        __syncthreads();
        if (BOTH(12)) GRID_BAR();
    }
    if (IN(13)) {
        pg8::DenseSched S{(const char*)OB, (const char*)W_OW, NTOK / 256, D / 256, G, bx, (size_t)256 * D * 2, (size_t)256 * D * 2, D / 64};
        pg8::EpiBf16 E{H3b, D};
        pg8::gemm_phase<pg8::EpiBf16, pg8::DenseSched, false>(lds + RING_OFF, D * 2, D * 2, S, E);
        if (BOTH(13)) GRID_BAR();
    }
    if (IN(14)) {
        PHASE_IDS();
        LAS int* L_E = (LAS int*)(lds + RING_OFF);
        LAS int* L_CNT = L_E + 128;
        LAS int* L_BASE = L_CNT + 8;
        LAS int* L_RANK = L_BASE + 8;
        const float* gp = args.in[I_LNG] + 2 * D + lane * 4; const float* bp = args.in[I_LNB] + 2 * D + lane * 4; f32x4 gv[4], bv[4];
#pragma unroll
        for (int j = 0; j < 4; ++j) { gv[j] = *(const GAS f32x4*)(gp + 256 * j); bv[j] = *(const GAS f32x4*)(bp + 256 * j); }
        f32x4 rw[16][2];
#pragma unroll
        for (int j = 0; j < 4; ++j)
#pragma unroll
            for (int q = 0; q < 4; ++q) { const float* wk = args.in[I_ROUTER] + (size_t)(j * 256 + lane * 4 + q) * 8; rw[j * 4 + q][0] = *(const GAS f32x4*)(wk); rw[j * 4 + q][1] = *(const GAS f32x4*)(wk + 4); }
        for (int rb = bx; rb < NTOK / 128; rb += G) {
            if (tid < 8) L_CNT[tid] = 0;
            __syncthreads();
            for (int i = 0; i < 16; ++i) {
                const int m = rb * 128 + wave * 16 + i;
                f32x4 v[4]; LN_LOAD_BF16RES(v, X2, H3b, m);
                float mean, rstd; LN_ROW_STATS(v, mean, rstd);
                float lg[8];
#pragma unroll
                for (int e = 0; e < 8; ++e) lg[e] = 0.f;
                GAS u32x2* o8 = (GAS u32x2*)(X3 + (size_t)m * D) + lane;
#pragma unroll
                for (int j = 0; j < 4; ++j) { const f32x4 y = v[j] * rstd * gv[j] + bv[j]; u32x2 w; w.x = cvt_pk_bf16(y[0], y[1]); w.y = cvt_pk_bf16(y[2], y[3]); o8[64 * j] = w;
#if MOE_FP8
                    *((GAS unsigned*)(X3Q + (size_t)m * D) + 64 * j + lane) = pk4_fp8(y[0], y[1], y[2], y[3]);
#endif
#pragma unroll
                    for (int q = 0; q < 4; ++q) { const f32x4 w0 = rw[j * 4 + q][0], w1 = rw[j * 4 + q][1];
                        lg[0] += y[q] * w0[0]; lg[1] += y[q] * w0[1]; lg[2] += y[q] * w0[2]; lg[3] += y[q] * w0[3]; lg[4] += y[q] * w1[0]; lg[5] += y[q] * w1[1]; lg[6] += y[q] * w1[2]; lg[7] += y[q] * w1[3]; } }
#pragma unroll
                for (int e = 0; e < 8; ++e) lg[e] = wave_sum(lg[e]);
                int e0 = 0; float v0 = lg[0];
#pragma unroll
                for (int e = 1; e < 8; ++e) if (lg[e] > v0) { v0 = lg[e]; e0 = e; }
                int e1 = (e0 == 0) ? 1 : 0; float v1 = (e0 == 0) ? lg[1] : lg[0];
#pragma unroll
                for (int e = 1; e < 8; ++e) if (e != e0 && lg[e] > v1) { v1 = lg[e]; e1 = e; }
                const float ex = __expf(v1 - v0), g0 = 1.f / (1.f + ex), g1 = ex / (1.f + ex);
                if (lane == 0) { L_E[wave * 16 + i] = e0 | (e1 << 8); GATES[(size_t)m * 2] = g0; GATES[(size_t)m * 2 + 1] = g1; }
            }
            __syncthreads();
            if (tid < 128) { const int ee = L_E[tid]; L_RANK[2 * tid] = __hip_atomic_fetch_add(&L_CNT[ee & 255], 1, __ATOMIC_RELAXED, __HIP_MEMORY_SCOPE_WORKGROUP); L_RANK[2 * tid + 1] = __hip_atomic_fetch_add(&L_CNT[ee >> 8], 1, __ATOMIC_RELAXED, __HIP_MEMORY_SCOPE_WORKGROUP); }
            __syncthreads();
            if (tid < 8) L_BASE[tid] = (int)__hip_atomic_fetch_add((unsigned*)(ctl + CW_ECNT + 64 * tid), (unsigned)L_CNT[tid], RLX_AGENT);
            __syncthreads();
            if (tid < 128) { const int ee = L_E[tid], e0 = ee & 255, e1 = ee >> 8, m = rb * 128 + tid; const int p0 = L_BASE[e0] + L_RANK[2 * tid], p1 = L_BASE[e1] + L_RANK[2 * tid + 1];
                ROW_TOK[e0 * NTOK + p0] = m; ROW_TOK[e1 * NTOK + p1] = m; *(GAS i32x4*)(TOK_INFO + (size_t)m * 4) = (i32x4){e0, p0, e1, p1}; }
            __syncthreads();
        }
        if (BOTH(14)) GRID_BAR();
    }
    if (IN(15)) {
#if MOE_FP8
        pg8::MoeSched S; S.A = (const char*)X3Q; S.Bt = (const char*)W_MOEIN; S.row_tok = ROW_TOK; S.nN = 2 * EXD / 256; S.nt = D / 128; S.G = G; S.c = bx; S.astep = 0; S.bexp = (size_t)2 * EXD * D; S.bstep = (size_t)256 * D; S.rowb = D;
        S.init((const unsigned*)(ctl + CW_ECNT));
        pg8::EpiSwiGLU8 E{(fp8*)MOEH, EXD, 1.0f / MOE_SC_IN};
        pg8::gemm_phase<pg8::EpiSwiGLU8, pg8::MoeSched, true, true>(lds + RING_OFF, D, D, S, E);
#else
        pg8::MoeSched S; S.A = (const char*)X3; S.Bt = (const char*)W_MOEIN; S.row_tok = ROW_TOK; S.nN = 2 * EXD / 256; S.nt = D / 64; S.G = G; S.c = bx; S.astep = 0; S.bexp = (size_t)2 * EXD * D * 2; S.bstep = (size_t)256 * D * 2; S.rowb = D * 2;
        S.init((const unsigned*)(ctl + CW_ECNT));
        pg8::EpiSwiGLU E{MOEH, EXD};
        pg8::gemm_phase<pg8::EpiSwiGLU, pg8::MoeSched, true>(lds + RING_OFF, D * 2, D * 2, S, E);
#endif
        if (BOTH(15)) GRID_BAR();
    }
    if (IN(16)) {
#if MOE_FP8
        pg8::MoeDownSched S; S.A = (const char*)MOEH; S.Bt = (const char*)W_MOEOUT; S.row_tok = ROW_TOK; S.nN = D / 256; S.nt = EXD / 128; S.G = G; S.c = bx; S.astep = (size_t)256 * EXD; S.bexp = (size_t)D * EXD; S.bstep = (size_t)256 * EXD; S.rowb = 0;
        S.init((const unsigned*)(ctl + CW_ECNT)); S.init2();
        pg8::EpiMoeDown E{YB, YSLAB, S.T0, (S.ts[NEXP] - S.T0) * 256, 1.0f / MOE_SC_OUT};
        pg8::gemm_phase<pg8::EpiMoeDown, pg8::MoeDownSched, false, true>(lds + RING_OFF, EXD, EXD, S, E);
#else
        pg8::MoeSched S; S.A = (const char*)MOEH; S.Bt = (const char*)W_MOEOUT; S.row_tok = ROW_TOK; S.nN = D / 256; S.nt = EXD / 64; S.G = G; S.c = bx; S.astep = (size_t)256 * EXD * 2; S.bexp = (size_t)D * EXD * 2; S.bstep = (size_t)256 * EXD * 2; S.rowb = 0;
        S.init((const unsigned*)(ctl + CW_ECNT));
        pg8::EpiBf16 E{YB, D};
        pg8::gemm_phase<pg8::EpiBf16, pg8::MoeSched, false>(lds + RING_OFF, EXD * 2, EXD * 2, S, E);
#endif
        if (BOTH(16)) GRID_BAR();
    }
    if (IN(17)) {
        PHASE_IDS();
        int ts[NEXP]; { int t = 0;
#pragma unroll
            for (int e = 0; e < NEXP; ++e) { const int c = (int)__builtin_amdgcn_readfirstlane(__hip_atomic_load((const unsigned*)(ctl + CW_ECNT + 64 * e), __ATOMIC_RELAXED, __HIP_MEMORY_SCOPE_AGENT)); ts[e] = t; t += (c + 255) >> 8; } }
        const float* gp = args.in[I_LNG] + 3 * D + lane * 4; const float* bp = args.in[I_LNB] + 3 * D + lane * 4; f32x4 gv[4], bv[4];
#pragma unroll
        for (int j = 0; j < 4; ++j) { gv[j] = *(const GAS f32x4*)(gp + 256 * j); bv[j] = *(const GAS f32x4*)(bp + 256 * j); }
        int T0_ = 0, tailr_ = 0;
#if MOE_FP8
        { int tt = 0;
#pragma unroll
          for (int e = 0; e < NEXP; ++e) { const int c = (int)__builtin_amdgcn_readfirstlane(__hip_atomic_load((const unsigned*)(ctl + CW_ECNT + 64 * e), __ATOMIC_RELAXED, __HIP_MEMORY_SCOPE_AGENT)); tt += (c + 255) >> 8; }
          const int per = (G % 4 == 0) ? G / 4 : 1; T0_ = (tt / per) * per; tailr_ = (tt - T0_) * 256; }
#else
        T0_ = 1 << 30;
#endif
#define P17_YROW(yv, r_) do { const int r__ = (r_); if ((r__ >> 8) < T0_) { const GAS u32x2* yp = (const GAS u32x2*)(YB + (size_t)r__ * D) + lane; \
                _Pragma("unroll") for (int j = 0; j < 4; ++j) { const u32x2 ya = yp[64 * j]; yv[j] = (f32x4){bf_lo(ya.x), bf_hi(ya.x), bf_lo(ya.y), bf_hi(ya.y)}; } } \
            else { const GAS f32x4* sp_ = (const GAS f32x4*)(YSLAB + (size_t)(r__ - T0_ * 256) * D) + lane; _Pragma("unroll") for (int j = 0; j < 4; ++j) yv[j] = sp_[64 * j]; \
                for (int ks = 1; ks < pg8::MOE_KS; ++ks) { const GAS f32x4* sq_ = sp_ + (size_t)ks * tailr_ * (D / 4); _Pragma("unroll") for (int j = 0; j < 4; ++j) yv[j] += sq_[64 * j]; } } } while (0)
#define P17_LOAD(v, m_) do { const i32x4 ti = *(const GAS i32x4*)(TOK_INFO + (size_t)(m_) * 4); const float g0 = GATES[(size_t)(m_) * 2], g1 = GATES[(size_t)(m_) * 2 + 1]; int t0 = 0, t1 = 0; \
            _Pragma("unroll") for (int e = 0; e < NEXP; ++e) { t0 = (ti.x == e) ? ts[e] : t0; t1 = (ti.z == e) ? ts[e] : t1; } \
            const int r0_ = t0 * 256 + ti.y, r1_ = t1 * 256 + ti.w; const GAS u32x2* xr = (const GAS u32x2*)(X3 + (size_t)(m_) * D) + lane; \
            if ((r0_ >> 8) < T0_ && (r1_ >> 8) < T0_) {     \
                const GAS u32x2* y0 = (const GAS u32x2*)(YB + (size_t)r0_ * D) + lane; const GAS u32x2* y1 = (const GAS u32x2*)(YB + (size_t)r1_ * D) + lane; \
                _Pragma("unroll") for (int j = 0; j < 4; ++j) { const u32x2 xa = __builtin_nontemporal_load(xr + 64 * j), ya = __builtin_nontemporal_load(y0 + 64 * j), yb = __builtin_nontemporal_load(y1 + 64 * j); \
                    v[j][0] = ALPHA * bf_lo(xa.x) + (g0 * bf_lo(ya.x) + g1 * bf_lo(yb.x)); v[j][1] = ALPHA * bf_hi(xa.x) + (g0 * bf_hi(ya.x) + g1 * bf_hi(yb.x)); \
                    v[j][2] = ALPHA * bf_lo(xa.y) + (g0 * bf_lo(ya.y) + g1 * bf_lo(yb.y)); v[j][3] = ALPHA * bf_hi(xa.y) + (g0 * bf_hi(ya.y) + g1 * bf_hi(yb.y)); } } \
            else { f32x4 ya_[4], yb_[4]; P17_YROW(ya_, r0_); P17_YROW(yb_, r1_); \
                _Pragma("unroll") for (int j = 0; j < 4; ++j) { const u32x2 xa = xr[64 * j]; \
                    v[j][0] = ALPHA * bf_lo(xa.x) + (g0 * ya_[j][0] + g1 * yb_[j][0]); v[j][1] = ALPHA * bf_hi(xa.x) + (g0 * ya_[j][1] + g1 * yb_[j][1]); \
                    v[j][2] = ALPHA * bf_lo(xa.y) + (g0 * ya_[j][2] + g1 * yb_[j][2]); v[j][3] = ALPHA * bf_hi(xa.y) + (g0 * ya_[j][3] + g1 * yb_[j][3]); } } } while (0)
#define P17_STORE(v, rstd, m_) do { GAS f32x4* o = (GAS f32x4*)(args.out + (size_t)(m_) * D) + lane; _Pragma("unroll") for (int j = 0; j < 4; ++j) __builtin_nontemporal_store(v[j] * rstd * gv[j] + bv[j], o + 64 * j); } while (0)
        for (int m = gw; m < NTOK; m += 2 * NGW) { const int m2 = m + NGW; const bool two = m2 < NTOK;
            f32x4 va[4], vb[4]; P17_LOAD(va, m); P17_LOAD(vb, (two ? m2 : m));
            float mean_a, rstd_a, mean_b, rstd_b; LN_ROW_STATS(va, mean_a, rstd_a); LN_ROW_STATS(vb, mean_b, rstd_b);
            P17_STORE(va, rstd_a, m); if (two) P17_STORE(vb, rstd_b, m2);
        }
    }
#undef IN
#undef BOTH
}

extern "C" void kernel_launch(void* const* d_in, const int* in_sizes, int n_in, void* d_out, int out_size, void* d_ws, size_t ws_size, hipStream_t stream) {
    static int grid = 0;
    if (grid == 0) {
        if (n_in != 24 || in_sizes[0] != NTOK * D || out_size != NTOK * D || ws_size < WS_END) { fprintf(stderr, "kernel_launch: unexpected shapes (n_in %d, in0 %d, out %d, ws %zu < %zu); nothing launched\n", n_in, n_in > 0 ? in_sizes[0] : -1, out_size, ws_size, (size_t)WS_END); grid = -1; return; }
        int dev = 0, cus = 0, per_cu = 0;
        if (hipGetDevice(&dev) != hipSuccess || hipDeviceGetAttribute(&cus, hipDeviceAttributeMultiprocessorCount, dev) != hipSuccess) { grid = -1; return; }
        if (hipFuncSetAttribute((const void*)yoco_fwd, hipFuncAttributeMaxDynamicSharedMemorySize, LDS_BYTES) != hipSuccess) { fprintf(stderr, "kernel_launch: hipFuncSetAttribute failed\n"); grid = -1; return; }
        if (hipOccupancyMaxActiveBlocksPerMultiprocessor(&per_cu, (const void*)yoco_fwd, NWAVES * 64, LDS_BYTES) != hipSuccess || per_cu < 1) { fprintf(stderr, "kernel_launch: occupancy query reports %d blocks per CU\n", per_cu); }
        (void)hipGetLastError();
        grid = cus;
    }
    if (grid < 0) return;
    if (hipMemsetAsync((char*)d_ws + WS_CTL, 0, CTL_ZERO_BYTES, stream) != hipSuccess) return;
    Args a{};
    for (int i = 0; i < 24; ++i) a.in[i] = (const float*)d_in[i];
    a.out = (float*)d_out; a.ws = (unsigned char*)d_ws;
    constexpr int NPH = 18;
    if (MK_N_LAUNCHES == 1) { a.ph_lo = 0; a.ph_hi = NPH; a.li = 0; hipLaunchKernelGGL(yoco_fwd, dim3(grid), dim3(NWAVES * 64), LDS_BYTES, stream, a); }
    else { for (int p = 0; p < NPH; ++p) { a.ph_lo = p; a.ph_hi = p + 1; a.li = p; hipLaunchKernelGGL(yoco_fwd, dim3(grid), dim3(NWAVES * 64), LDS_BYTES, stream, a); } }
#ifdef PROBE_MASK
    for (int p = 0; p < NPH + 8; ++p) if ((PROBE_MASK >> p) & 1) { a.ph_lo = p; a.ph_hi = p + 1; a.li = 1; hipLaunchKernelGGL(yoco_fwd, dim3(grid), dim3(NWAVES * 64), LDS_BYTES, stream, a); }
#endif
}
```

```cpp
#include <hip/hip_runtime.h>
#include <cstdio>
#include <cstdint>

#ifndef MOE_FP8
#define MOE_FP8 1
#endif
#ifndef FFN_DOWN_FP8
#define FFN_DOWN_FP8 1
#endif
#ifndef PG8_ALIGN_EPI
#define PG8_ALIGN_EPI 1
#endif
#ifndef MLA_ABSORB
#define CONV_IN_ATTN 1
#define MLA_ABSORB 1
#endif
#ifndef MK_N_LAUNCHES
#define MK_N_LAUNCHES 1
#endif

#define GAS __attribute__((address_space(1)))
#define LAS __attribute__((address_space(3)))
typedef unsigned short bf16;
typedef short bf16x8 __attribute__((ext_vector_type(8)));
typedef short s16x4 __attribute__((ext_vector_type(4)));
typedef float f32x2 __attribute__((ext_vector_type(2)));
typedef float f32x4 __attribute__((ext_vector_type(4)));
typedef float f32x16 __attribute__((ext_vector_type(16)));
typedef unsigned u32x2 __attribute__((ext_vector_type(2)));
typedef unsigned u32x4 __attribute__((ext_vector_type(4)));
typedef int i32x4 __attribute__((ext_vector_type(4)));
typedef int i32x8 __attribute__((ext_vector_type(8)));
typedef unsigned char fp8;

constexpr int D = 1024, BATCH = 16, SEQ = 2048, NTOK = BATCH * SEQ;
constexpr int S5G = 64, S5C = 16, S5P = 64;
constexpr int LCH = 16, NCHUNK = SEQ / LCH, NBC = BATCH * NCHUNK;
constexpr int A3_LD = 384;
constexpr int HEADS = 8, QKN = 128, QKR = 64, VD = 128, QL = 256, KVL = 128;
constexpr int QKVA_N = 512, QKVB_N = 3584, QKVB_K = 384, QW = HEADS * (QKN + QKR);
constexpr int FFN = 2816, NEXP = 8, EXD = 3584;
constexpr float ALPHA = 1.41421356237f, LN_EPS = 1e-5f, RMS_EPS = 1e-6f;
constexpr float MOE_SC_IN = 32.0f, MOE_SC_OUT = 128.0f;
constexpr int MOE_ROWS = 2 * NTOK + NEXP * 256;

constexpr size_t MiB = 1u << 20;
constexpr size_t WS_CTL = 0, CTL_ZERO_BYTES = 128 * 1024;
constexpr size_t WS_MOEIN = 1 * MiB;
constexpr size_t WS_MOEOUT = WS_MOEIN + 112 * MiB;
constexpr size_t WS_FFNIN = WS_MOEOUT + 56 * MiB;
constexpr size_t WS_FFNOUT = WS_FFNIN + 11 * MiB;
constexpr size_t WS_GLU = WS_FFNOUT + 6 * MiB;
constexpr size_t WS_OW = WS_GLU + 4 * MiB;
constexpr size_t WS_QKVB = WS_OW + 2 * MiB;
constexpr size_t WS_QKVA = WS_QKVB + 3 * MiB;
constexpr size_t WS_S5ST = WS_QKVA + 1 * MiB;
constexpr size_t WS_S5W3 = WS_S5ST + 8 * MiB;
constexpr size_t WS_ROPE = WS_S5W3 + 12 * MiB;
constexpr size_t WS_PTAB = WS_ROPE + 1 * MiB;
constexpr size_t WS_BBTAB = WS_PTAB + 1 * MiB;
constexpr size_t WS_ACTS = WS_BBTAB + 1 * MiB;
constexpr size_t WS_A3 = WS_ACTS;
constexpr size_t WS_SEND = WS_A3 + 96 * MiB;
constexpr size_t WS_ACT = WS_SEND + 64 * MiB;
constexpr size_t WS_H = WS_ACT + 64 * MiB;
constexpr size_t WS_X1 = WS_H + 128 * MiB;
constexpr size_t WS_FFNH = WS_X1 + 64 * MiB;
constexpr size_t WS_X2 = WS_ACTS;
constexpr size_t WS_QKVAF = WS_X2 + 64 * MiB;
constexpr size_t WS_CQKV = WS_QKVAF + 64 * MiB;
constexpr size_t WS_KROPE = WS_CQKV + 24 * MiB;
constexpr size_t WS_QKV = WS_KROPE + 4 * MiB;
constexpr size_t WS_H3 = WS_QKV + 224 * MiB;
constexpr size_t WS_O = WS_H3 + 128 * MiB;
constexpr size_t WS_X3 = WS_ACTS;
constexpr size_t WS_MOEH = WS_X3 + 64 * MiB;
constexpr size_t WS_Y = WS_MOEH + 462 * MiB;
constexpr size_t WS_ROUTE = WS_Y + 132 * MiB;
constexpr size_t WS_END = WS_ROUTE + 2 * MiB;
static_assert(WS_FFNH + 176 * MiB <= WS_END && WS_O + 64 * MiB <= WS_END, "d_ws map");
static_assert(WS_END <= 896 * MiB, "d_ws map exceeds 4x the largest input");
static_assert(WS_H3 >= WS_QKV + (size_t)NTOK * QKVB_N * 2, "d_ws map");

constexpr int CW_BAR = 4096;
constexpr int CW_ECNT = 16384;

constexpr int RING_OFF = 0, RING_BYTES = 131072;
constexpr int IDX_OFF = 131072;
constexpr int LDSCTL_OFF = 139264, MISC_OFF = LDSCTL_OFF + 320;
constexpr int LDS_BYTES = 147456;
constexpr int NWAVES = 8;

#define RLX_AGENT __ATOMIC_RELAXED, __HIP_MEMORY_SCOPE_AGENT
#define LDS_WAIT() asm volatile("s_waitcnt lgkmcnt(0)" ::: "memory")
#define VM_WAIT() asm volatile("s_waitcnt vmcnt(0)" ::: "memory")

__device__ __forceinline__ unsigned cvt_pk_bf16(float lo, float hi) { unsigned r; asm volatile("v_cvt_pk_bf16_f32 %0, %1, %2" : "=v"(r) : "v"(lo), "v"(hi)); return r; }
__device__ __forceinline__ unsigned pk4_fp8(float a, float b, float c, float d) { int r = 0; r = __builtin_amdgcn_cvt_pk_fp8_f32(a, b, r, false); r = __builtin_amdgcn_cvt_pk_fp8_f32(c, d, r, true); return (unsigned)r; }
__device__ __forceinline__ float bf_lo(unsigned w) { return __uint_as_float(w << 16); }
__device__ __forceinline__ float bf_hi(unsigned w) { return __uint_as_float(w & 0xffff0000u); }
template <int CTRL> __device__ __forceinline__ float dpp_mov(float v) { return __builtin_bit_cast(float, __builtin_amdgcn_update_dpp(0, __builtin_bit_cast(int, v), CTRL, 0xf, 0xf, true)); }
__device__ __forceinline__ float wave_sum(float v) {
    v += dpp_mov<0xB1>(v);
    v += dpp_mov<0x4E>(v);
    v += dpp_mov<0x141>(v);
    v += dpp_mov<0x140>(v);
    { auto r = __builtin_amdgcn_permlane16_swap(__float_as_uint(v), __float_as_uint(v), false, false); v = __uint_as_float(r[0]) + __uint_as_float(r[1]); }
    { auto r = __builtin_amdgcn_permlane32_swap(__float_as_uint(v), __float_as_uint(v), false, false); v = __uint_as_float(r[0]) + __uint_as_float(r[1]); }
    return v;
}
__device__ __forceinline__ float sigmoid_f(float x) { return __builtin_amdgcn_rcpf(1.0f + __builtin_amdgcn_exp2f(-1.4426950408889634f * x)); }
__device__ __forceinline__ float gelu_tanh_f(float x) { return x * sigmoid_f(1.5957691216057308f * x * (1.0f + 0.044715f * x * x)); }
__device__ __forceinline__ f32x2 sigmoid2_f(f32x2 x) { const f32x2 t = x * -1.4426950408889634f; f32x2 e; e.x = __builtin_amdgcn_exp2f(t.x); e.y = __builtin_amdgcn_exp2f(t.y); const f32x2 d = e + 1.0f; f32x2 r; r.x = __builtin_amdgcn_rcpf(d.x); r.y = __builtin_amdgcn_rcpf(d.y); return r; }
__device__ __forceinline__ f32x2 gelu_tanh2_f(f32x2 x) { const f32x2 x2 = x * x; const f32x2 z = (x * 1.5957691216057308f) * (x2 * 0.044715f + 1.0f); return x * sigmoid2_f(z); }

namespace pg8 {
constexpr int BM = 256, BK = 64, HALF = 128, HTB = HALF * BK * 2, STAGE_BYTES = 8 * HTB, NXCD = 8, WGM = 8;
__host__ __device__ __forceinline__ int lds_byte(int r, int c) { const int st = (r >> 4) * 2 + (c >> 5), rr = r & 15, cc = c & 31, ob = rr * 64 + cc * 2; return st * 1024 + (ob ^ (((ob >> 9) & 1) << 5)); }
__host__ __device__ __forceinline__ void stage_rc(int b, int& R, int& C) { const int st = b / 1024, sb = b % 1024, swz = sb ^ (((sb >> 9) & 1) << 5); R = (st >> 1) * 16 + swz / 64; C = (st & 1) * 32 + (swz % 64) / 2; }
__host__ __device__ __forceinline__ int perm32(int rho) { const int n = rho >> 4, i = rho & 15; return 8 * (i >> 2) + 4 * n + (i & 3); }

struct Unit { int pm, pn, aux, aux2, nt; const char* a; const char* b; };

__device__ __forceinline__ bool tile_of(long L, int nM, int nN, int& pm, int& pn) {
    const int nwg = nM * nN; if (L >= nwg) return false;
    int wgid = (int)L; { const int q = nwg / NXCD, r = nwg % NXCD, xcd = wgid % NXCD, off = wgid / NXCD; wgid = (xcd < r ? xcd * (q + 1) : r * (q + 1) + (xcd - r) * q) + off; }
    const int nig = WGM * nN, gid = wgid / nig, fm = gid * WGM, gsz = (nM - fm) < WGM ? (nM - fm) : WGM;
    pm = fm + ((wgid % nig) % gsz); pn = (wgid % nig) / gsz; return true;
}

template <class E, class = void> struct epi_after_drain { static constexpr bool value = false; };
template <class E> struct epi_after_drain<E, decltype((void)E::AFTER_DRAIN)> { static constexpr bool value = E::AFTER_DRAIN; };
template <bool F8> struct frag_sel;
template <> struct frag_sel<false> { struct A4 { bf16x8 v[4][2]; }; struct B2 { bf16x8 v[2][2]; }; };
template <> struct frag_sel<true>  { struct A4 { i32x8 v[4]; };     struct B2 { i32x8 v[2]; }; };
template <class Epi, class Sched, bool GATHER, bool FP8 = false>
__device__ __forceinline__ void gemm_phase(LAS unsigned char* lds, const int ldb_, const int lda_, const Sched& S, const Epi& E) {
    int K = ldb_, lda = lda_; asm volatile("" : "+s"(K), "+s"(lda));
    int tid_ = threadIdx.x; asm volatile("" : "+v"(tid_));
    const int tid = tid_, wid = __builtin_amdgcn_readfirstlane(tid >> 6), lane = tid & 63, wr = wid >> 2, wc = wid & 3, fr = lane & 15, fq = lane >> 4;
    int R[2], C[2]; unsigned voffB[2], ca[4];
#pragma unroll
    for (int i = 0; i < 2; ++i) { stage_rc(tid * 16 + i * 8192, R[i], C[i]); const int Rb = Epi::PERM ? ((R[i] & ~31) + perm32(R[i] & 31)) : R[i];
        voffB[i] = (unsigned)(Rb * K + C[i] * 2); ca[i] = (unsigned)(R[i] * lda + C[i] * 2); ca[2 + i] = (unsigned)((HALF + R[i]) * lda + C[i] * 2); }
    const size_t kstep = (size_t)(BK * 2);
    const size_t hstepB = (size_t)HALF * K;
    const unsigned ldsw = (unsigned)wid * 1024u;
    const int aoff = lds_byte(wr * 64 + fr, fq * 8), boff = lds_byte(wc * 32 + fr, fq * 8);
#define PG8_SA(b, h) (((b) * 2 + (h)) * HTB)
#define PG8_SB(b, h) ((4 + (b) * 2 + (h)) * HTB)
#define PG8_STAGE(bufoff, gbase, o0, o1) do { \
        __builtin_amdgcn_global_load_lds((const unsigned*)((const char*)(gbase) + (o0)), (LAS unsigned*)(lds + (bufoff) + ldsw), 16, 0, 0); \
        __builtin_amdgcn_global_load_lds((const unsigned*)((const char*)(gbase) + (o1)), (LAS unsigned*)(lds + (bufoff) + ldsw + 8192), 16, 0, 0); } while (0)
#define PG8_STAGEB(bufoff, gbase) PG8_STAGE(bufoff, gbase, voffB[0], voffB[1])
#define PG8_LD16(off) (*(const LAS i32x4*)(lds + (off)))
#define PG8_LDA(dst, b, h) do { _Pragma("unroll") for (int m = 0; m < 4; ++m) { \
        if constexpr (FP8) { const i32x4 lo_ = PG8_LD16(PG8_SA(b, h) + aoff + m * 2048), hi_ = PG8_LD16(PG8_SA(b, h) + aoff + m * 2048 + 1024); dst.v[m] = __builtin_shufflevector(lo_, hi_, 0, 1, 2, 3, 4, 5, 6, 7); } \
        else { _Pragma("unroll") for (int k = 0; k < 2; ++k) dst.v[m][k] = *(const LAS bf16x8*)(lds + PG8_SA(b, h) + aoff + m * 2048 + k * 1024); } } } while (0)
#define PG8_LDB(dst, b, h) do { _Pragma("unroll") for (int n = 0; n < 2; ++n) { \
        if constexpr (FP8) { const i32x4 lo_ = PG8_LD16(PG8_SB(b, h) + boff + n * 2048), hi_ = PG8_LD16(PG8_SB(b, h) + boff + n * 2048 + 1024); dst.v[n] = __builtin_shufflevector(lo_, hi_, 0, 1, 2, 3, 4, 5, 6, 7); } \
        else { _Pragma("unroll") for (int k = 0; k < 2; ++k) dst.v[n][k] = *(const LAS bf16x8*)(lds + PG8_SB(b, h) + boff + n * 2048 + k * 1024); } } } while (0)
#define PG8_MMA(ai, bj, At, Bt) do { __builtin_amdgcn_s_setprio(1); \
        if constexpr (FP8) { _Pragma("unroll") for (int m = 0; m < 4; ++m) _Pragma("unroll") for (int n = 0; n < 2; ++n) \
            asm volatile("v_mfma_f32_16x16x128_f8f6f4 %0, %1, %2, %0" : "+v"(acc[ai][bj][m][n]) : "v"(Bt.v[n]), "v"(At.v[m])); } \
        else { _Pragma("unroll") for (int m = 0; m < 4; ++m) _Pragma("unroll") for (int n = 0; n < 2; ++n) _Pragma("unroll") for (int k = 0; k < 2; ++k) \
            acc[ai][bj][m][n] = __builtin_amdgcn_mfma_f32_16x16x32_bf16(Bt.v[n][k], At.v[m][k], acc[ai][bj][m][n], 0, 0, 0); } \
        __builtin_amdgcn_s_setprio(0); } while (0)
#define PG8_WAIT_V(n) asm volatile("s_waitcnt vmcnt(" #n ")" ::: "memory")
#define PG8_WAIT_L(n) asm volatile("s_waitcnt lgkmcnt(" #n ")" ::: "memory")
#define PG8_BAR __builtin_amdgcn_s_barrier()
#define PG8_SCHED __builtin_amdgcn_sched_barrier(0)
    Unit cur, nxt; int ui = 0;
    if (!S.next(0, cur)) return;
    if constexpr (GATHER) S.gather(cur, R, C, ca);
    f32x4 acc[2][2][4][2];
#pragma unroll
    for (int a = 0; a < 2; ++a)
#pragma unroll
        for (int b = 0; b < 2; ++b)
#pragma unroll
            for (int m = 0; m < 4; ++m)
#pragma unroll
                for (int n = 0; n < 2; ++n) acc[a][b][m][n] = (f32x4){0.f, 0.f, 0.f, 0.f};
    typedef typename frag_sel<FP8>::A4 FragA; typedef typename frag_sel<FP8>::B2 FragB;
    FragA At; FragB B0, B1;
    const char* cA = cur.a; const char* cB = cur.b;
    PG8_STAGEB(PG8_SB(0, 0), cB); PG8_STAGEB(PG8_SB(0, 1), cB + hstepB); PG8_STAGE(PG8_SA(0, 0), cA, ca[0], ca[1]); PG8_STAGE(PG8_SA(0, 1), cA, ca[2], ca[3]);
    if (wr == 1) PG8_BAR;
    PG8_WAIT_V(2); PG8_BAR;
    PG8_STAGEB(PG8_SB(1, 0), cB + kstep); PG8_STAGE(PG8_SA(1, 0), cA + kstep, ca[0], ca[1]); PG8_STAGEB(PG8_SB(1, 1), cB + hstepB + kstep);
    PG8_WAIT_V(6); PG8_BAR;
    for (;;) {
        const bool has_next = S.next(ui + 1, nxt);
        const char* nA = has_next ? nxt.a : cA; const char* nB = has_next ? nxt.b : cB;
        const int nt = cur.nt;
        for (int t = 0; t < nt; t += 2) {
            const bool last = (t == nt - 2);
            const char* a1 = cA + (size_t)(t + 1) * kstep;
            const char* a2 = last ? nA : cA + (size_t)(t + 2) * kstep; const char* b2 = last ? nB : cB + (size_t)(t + 2) * kstep;
            const char* a3 = a2 + kstep; const char* b3 = b2 + kstep;
            PG8_LDB(B0, 0, 0); PG8_LDB(B1, 0, 1); PG8_SCHED; PG8_LDA(At, 0, 0); PG8_STAGE(PG8_SA(1, 1), a1, ca[2], ca[3]);
            PG8_WAIT_V(8); PG8_WAIT_L(0); PG8_BAR; PG8_MMA(0, 0, At, B0); PG8_MMA(0, 1, At, B1); PG8_BAR; PG8_SCHED;
            if constexpr (GATHER) { if (last && has_next) {
                int t2 = tid; asm volatile("" : "+v"(t2)); int R2[2], C2[2]; stage_rc(t2 * 16, R2[0], C2[0]); stage_rc(t2 * 16 + 8192, R2[1], C2[1]);
#pragma unroll
                for (int k = 0; k < 4; ++k) ca[k] = S.off_of(*(const LAS int*)(lds + IDX_OFF + wid * 1024 + k * 256 + lane * 4), C2[k & 1]); } }
            PG8_LDA(At, 0, 1);
            if constexpr (GATHER) { if (t == 0 && has_next) {
                int t2 = tid; asm volatile("" : "+v"(t2)); int R2[2], C2[2]; stage_rc(t2 * 16, R2[0], C2[0]); stage_rc(t2 * 16 + 8192, R2[1], C2[1]);
#pragma unroll
                for (int k = 0; k < 4; ++k) __builtin_amdgcn_global_load_lds((const unsigned*)S.idx_src(nxt, (k >> 1) * HALF + R2[k & 1]), (LAS unsigned*)(lds + IDX_OFF + wid * 1024 + k * 256), 4, 0, 0); } }
            PG8_STAGEB(PG8_SB(0, 0), b2); PG8_STAGEB(PG8_SB(0, 1), b2 + hstepB); PG8_STAGE(PG8_SA(0, 0), a2, ca[0], ca[1]);
            PG8_WAIT_V(8); PG8_WAIT_L(0); PG8_BAR; PG8_MMA(1, 0, At, B0); PG8_MMA(1, 1, At, B1); PG8_BAR; PG8_SCHED;
            PG8_LDB(B0, 1, 0); PG8_LDB(B1, 1, 1); PG8_SCHED; PG8_LDA(At, 1, 0); PG8_STAGE(PG8_SA(0, 1), a2, ca[2], ca[3]);
            PG8_WAIT_V(8); PG8_WAIT_L(0); PG8_BAR; PG8_MMA(0, 0, At, B0); PG8_MMA(0, 1, At, B1); PG8_BAR; PG8_SCHED;
            PG8_LDA(At, 1, 1); PG8_STAGEB(PG8_SB(1, 0), b3); PG8_STAGEB(PG8_SB(1, 1), b3 + hstepB); PG8_STAGE(PG8_SA(1, 0), a3, ca[0], ca[1]);
            PG8_WAIT_V(8); PG8_WAIT_L(0); PG8_BAR; PG8_MMA(1, 0, At, B0); PG8_MMA(1, 1, At, B1); PG8_BAR; PG8_SCHED;
        }
        if (PG8_ALIGN_EPI) { if (wr == 0) PG8_BAR; }
        if constexpr (FP8) asm volatile("s_nop 15\n\ts_nop 15" ::: "memory");
        if constexpr (!epi_after_drain<Epi>::value) E(acc, cur, wr, wc, fr, fq);
        if (!has_next) break;
#pragma unroll
        for (int a = 0; a < 2; ++a)
#pragma unroll
            for (int b = 0; b < 2; ++b)
#pragma unroll
                for (int m = 0; m < 4; ++m)
#pragma unroll
                    for (int n = 0; n < 2; ++n) acc[a][b][m][n] = (f32x4){0.f, 0.f, 0.f, 0.f};
        cur = nxt; cA = nA; cB = nB; ++ui;
        if (PG8_ALIGN_EPI) { if (wr == 1) PG8_BAR; }
    }
    PG8_WAIT_V(0);
    if (!PG8_ALIGN_EPI) { if (wr == 0) PG8_BAR; }
    PG8_BAR;
    if constexpr (epi_after_drain<Epi>::value) E.after(acc, cur, wr, wc, fr, fq, lds, lane);
#undef PG8_SA
#undef PG8_SB
#undef PG8_STAGE
#undef PG8_STAGEB
#undef PG8_LDA
#undef PG8_LD16
#undef PG8_LDB
#undef PG8_MMA
#undef PG8_WAIT_V
#undef PG8_WAIT_L
#undef PG8_BAR
#undef PG8_SCHED
}

struct DenseSched {
    const char* A; const char* Bt; int nM, nN, G, c; size_t astep, bstep; int nt;
    __device__ __forceinline__ bool next(int i, Unit& u) const { if (!tile_of((long)i * G + c, nM, nN, u.pm, u.pn)) return false; u.aux = 0; u.aux2 = -1; u.nt = nt; u.a = A + (size_t)u.pm * astep; u.b = Bt + (size_t)u.pn * bstep; return true; }
};
struct QkvbSched {
    const char* A; const char* Bt; int G, c;
    __device__ __forceinline__ bool next(int i, Unit& u) const { if (!tile_of((long)i * G + c, NTOK / 256, QKVB_N / 256, u.pm, u.pn)) return false; u.aux = 0; u.aux2 = -1;
        const bool kv = u.pn >= QW / 256; u.nt = kv ? 2 : 4; const size_t ko = kv ? (size_t)QL * 2 : 0;
        u.a = A + (size_t)u.pm * 256 * QKVB_K * 2 + ko; u.b = Bt + (size_t)u.pn * 256 * QKVB_K * 2 + ko; return true; }
};
struct GroupSched {
    const char* A; const char* Bt; int G, c; size_t agrp, bgrp, astep; int nt;
    __device__ __forceinline__ bool next(int i, Unit& u) const {
        const long L = (long)i * G + c; if (L >= 512) return false;
        const int xcd = (int)(L % 8), off = (int)(L / 8), w = xcd * 64 + off;
        u.aux = w >> 3; u.aux2 = -1; u.pm = w & 7; u.pn = 0; u.nt = nt; u.a = A + (size_t)u.aux * agrp + (size_t)u.pm * astep; u.b = Bt + (size_t)u.aux * bgrp; return true; }
};
struct MoeSched {
    const char* A; const char* Bt; const int* row_tok; int nN, G, c, nt; size_t astep, bexp, bstep; int rowb;
    int cnt[NEXP], ts[NEXP + 1];
    __device__ __forceinline__ void init(const unsigned* ecnt) {
        int t = 0;
#pragma unroll
        for (int e = 0; e < NEXP; ++e) { cnt[e] = (int)__builtin_amdgcn_readfirstlane(__hip_atomic_load(ecnt + 64 * e, __ATOMIC_RELAXED, __HIP_MEMORY_SCOPE_AGENT)); ts[e] = t; t += (cnt[e] + 255) >> 8; }
        ts[NEXP] = t;
    }
    __device__ __forceinline__ int expert_of(int T) const { int e = 0;
#pragma unroll
        for (int k = 1; k < NEXP; ++k) e += (T >= ts[k]) ? 1 : 0;
        return e; }
    __device__ __forceinline__ bool next(int i, Unit& u) const {
        if (!tile_of((long)i * G + c, ts[NEXP], nN, u.pm, u.pn)) return false;
        const int e = expert_of(u.pm); u.aux = e; u.aux2 = -1; u.nt = nt; u.a = A + (size_t)u.pm * astep; u.b = Bt + (size_t)e * bexp + (size_t)u.pn * bstep; return true; }
    __device__ __forceinline__ const int* idx_src(const Unit& u, int row) const {
        int tse = 0, ce = 0;
#pragma unroll
        for (int k = 0; k < NEXP; ++k) { tse = (u.aux == k) ? ts[k] : tse; ce = (u.aux == k) ? cnt[k] : ce; }
        int r = (u.pm - tse) * 256 + row; r = (r < ce) ? r : 0;
        return row_tok + u.aux * NTOK + r; }
    __device__ __forceinline__ unsigned off_of(int tok, int Ci) const { return (unsigned)tok * (unsigned)rowb + (unsigned)Ci * 2u; }
    __device__ __forceinline__ void gather(const Unit& u, const int (&R)[2], const int (&C)[2], unsigned (&off)[4]) const {
        int tok[4];
#pragma unroll
        for (int h = 0; h < 2; ++h)
#pragma unroll
            for (int i = 0; i < 2; ++i) tok[h * 2 + i] = *idx_src(u, h * HALF + R[i]);
#pragma unroll
        for (int h = 0; h < 2; ++h)
#pragma unroll
            for (int i = 0; i < 2; ++i) off[h * 2 + i] = off_of(tok[h * 2 + i], C[i]);
    }
};

constexpr int MOE_KS = 7;
struct MoeDownSched : MoeSched {
    int T0, ntail;
    __device__ __forceinline__ void init2() { const int T = ts[NEXP], per = (G % nN == 0) ? G / nN : 1; T0 = (T / per) * per; ntail = (T - T0) * nN * MOE_KS; }
    __device__ __forceinline__ bool next(int i, Unit& u) const {
        const long L = (long)i * G + c; const int nnorm = T0 * nN;
        if (L < nnorm) { tile_of(L, T0, nN, u.pm, u.pn); u.aux2 = -1; u.nt = nt; const int e = expert_of(u.pm); u.aux = e; u.a = A + (size_t)u.pm * astep; u.b = Bt + (size_t)e * bexp + (size_t)u.pn * bstep; return true; }
        const long L2 = L - nnorm; if (L2 >= ntail) return false;
        const int ks = (int)(L2 % MOE_KS), r = (int)(L2 / MOE_KS); u.pn = r % nN; u.pm = T0 + r / nN; u.aux2 = ks; u.nt = nt / MOE_KS;
        const int e = expert_of(u.pm); u.aux = e; const size_t ko = (size_t)ks * (nt / MOE_KS) * 128;
        u.a = A + (size_t)u.pm * astep + ko; u.b = Bt + (size_t)e * bexp + (size_t)u.pn * bstep + ko; return true; }
};
struct EpiMoeDown {
    static constexpr bool PERM = true;
    bf16* O; float* slab; int T0, tail_rows; float s;
    __device__ __forceinline__ void operator()(const f32x4 (&acc)[2][2][4][2], const Unit& u, int wr, int wc, int fr, int fq) const {
        const int col0 = u.pn * BM + wc * 32 + 8 * fq;
        if (u.aux2 < 0) { const int row0 = u.pm * BM + wr * 64 + fr;
#pragma unroll
            for (int ai = 0; ai < 2; ++ai)
#pragma unroll
                for (int m = 0; m < 4; ++m) { bf16* rowp = O + (size_t)(row0 + ai * HALF + m * 16) * D + col0;
#pragma unroll
                    for (int bj = 0; bj < 2; ++bj) { const f32x4 v0 = acc[ai][bj][m][0] * s, v1 = acc[ai][bj][m][1] * s;
                        u32x4 w; w.x = cvt_pk_bf16(v0[0], v0[1]); w.y = cvt_pk_bf16(v0[2], v0[3]); w.z = cvt_pk_bf16(v1[0], v1[1]); w.w = cvt_pk_bf16(v1[2], v1[3]);
                        *(u32x4*)(rowp + bj * HALF) = w; } }
        } else { const int row0 = u.aux2 * tail_rows + (u.pm - T0) * BM + wr * 64 + fr;
#pragma unroll
            for (int ai = 0; ai < 2; ++ai)
#pragma unroll
                for (int m = 0; m < 4; ++m) { float* rowp = slab + (size_t)(row0 + ai * HALF + m * 16) * D + col0;
#pragma unroll
                    for (int bj = 0; bj < 2; ++bj) { *(f32x4*)(rowp + bj * HALF) = acc[ai][bj][m][0] * s; *(f32x4*)(rowp + bj * HALF + 4) = acc[ai][bj][m][1] * s; } }
        }
    }
};

struct EpiF32 {
    static constexpr bool PERM = false;
    float* Cp; int ldc;
    __device__ __forceinline__ void operator()(const f32x4 (&acc)[2][2][4][2], const Unit& u, int wr, int wc, int fr, int fq) const {
        const int row0 = u.pm * BM + wr * 64 + fr, col0 = u.pn * BM + wc * 32 + 4 * fq;
#pragma unroll
        for (int ai = 0; ai < 2; ++ai)
#pragma unroll
            for (int m = 0; m < 4; ++m) { float* rowp = Cp + (size_t)(row0 + ai * HALF + m * 16) * ldc + col0;
#pragma unroll
                for (int bj = 0; bj < 2; ++bj)
#pragma unroll
                    for (int n = 0; n < 2; ++n) *(f32x4*)(rowp + bj * HALF + n * 16) = acc[ai][bj][m][n]; }
    }
};
struct EpiS1 {
    static constexpr bool PERM = false;
    float* Send;
    __device__ __forceinline__ void operator()(const f32x4 (&acc)[2][2][4][2], const Unit& u, int wr, int wc, int fr, int fq) const {
        float* base = Send + ((size_t)u.aux * NBC + u.pm * BM + wr * 64 + fr) * 128 + wc * 32 + 4 * fq;
#pragma unroll
        for (int ai = 0; ai < 2; ++ai)
#pragma unroll
            for (int m = 0; m < 4; ++m)
#pragma unroll
                for (int n = 0; n < 2; ++n) *(f32x4*)(base + (size_t)(ai * HALF + m * 16) * 128 + n * 16) = acc[ai][0][m][n];
    }
};
struct EpiS3 {
    static constexpr bool PERM = true;
    bf16* act;
    __device__ __forceinline__ void operator()(const f32x4 (&acc)[2][2][4][2], const Unit& u, int wr, int wc, int fr, int fq) const {
        const int g = u.aux;
#pragma unroll
        for (int ai = 0; ai < 2; ++ai)
#pragma unroll
            for (int m = 0; m < 4; ++m) { const int bc = u.pm * BM + ai * HALF + wr * 64 + m * 16 + fr, b = bc >> 7, c = bc & 127;
#pragma unroll
                for (int bj = 0; bj < 2; ++bj) { const int tl = 8 * bj + 2 * wc + (fq >> 1);
                    const f32x4 v0 = acc[ai][bj][m][0], v1 = acc[ai][bj][m][1];
                    const f32x2 g0 = gelu_tanh2_f((f32x2){v0[0], v0[1]}), g1 = gelu_tanh2_f((f32x2){v0[2], v0[3]}), g2 = gelu_tanh2_f((f32x2){v1[0], v1[1]}), g3 = gelu_tanh2_f((f32x2){v1[2], v1[3]});
                    u32x4 w; w.x = cvt_pk_bf16(g0.x, g0.y); w.y = cvt_pk_bf16(g1.x, g1.y); w.z = cvt_pk_bf16(g2.x, g2.y); w.w = cvt_pk_bf16(g3.x, g3.y);
                    *(u32x4*)(act + (size_t)(b * SEQ + c * LCH + tl) * D + g * 16 + (fq & 1) * 8) = w; } }
    }
};
struct EpiGLU {
    static constexpr bool PERM = true;
    bf16* out;
    __device__ __forceinline__ void operator()(const f32x4 (&acc)[2][2][4][2], const Unit& u, int wr, int wc, int fr, int fq) const {
        const int row0 = u.pm * BM + wr * 64 + fr, col0 = u.pn * HALF + wc * 32 + 8 * fq;
#pragma unroll
        for (int ai = 0; ai < 2; ++ai)
#pragma unroll
            for (int m = 0; m < 4; ++m) { float h[8];
#pragma unroll
                for (int n = 0; n < 2; ++n)
#pragma unroll
                    for (int jp = 0; jp < 2; ++jp) { const f32x2 hv = (f32x2){acc[ai][0][m][n][2 * jp], acc[ai][0][m][n][2 * jp + 1]} * sigmoid2_f((f32x2){acc[ai][1][m][n][2 * jp], acc[ai][1][m][n][2 * jp + 1]});
                        h[n * 4 + 2 * jp] = hv.x; h[n * 4 + 2 * jp + 1] = hv.y; }
                u32x4 w; w.x = cvt_pk_bf16(h[0], h[1]); w.y = cvt_pk_bf16(h[2], h[3]); w.z = cvt_pk_bf16(h[4], h[5]); w.w = cvt_pk_bf16(h[6], h[7]);
                *(u32x4*)(out + (size_t)(row0 + ai * HALF + m * 16) * D + col0) = w; }
    }
};
struct EpiSwiGLU {
    static constexpr bool PERM = true;
    bf16* Hb; int ldh;
    __device__ __forceinline__ void operator()(const f32x4 (&acc)[2][2][4][2], const Unit& u, int wr, int wc, int fr, int fq) const {
        const int row0 = u.pm * BM + wr * 64 + fr, col0 = u.pn * HALF + wc * 32 + 8 * fq;
#pragma unroll
        for (int ai = 0; ai < 2; ++ai)
#pragma unroll
            for (int m = 0; m < 4; ++m) { float h[8];
#pragma unroll
                for (int n = 0; n < 2; ++n)
#pragma unroll
                    for (int j = 0; j < 4; ++j) { const float g = acc[ai][0][m][n][j], uu = acc[ai][1][m][n][j]; h[n * 4 + j] = g * sigmoid_f(g) * uu; }
                u32x4 w; w.x = cvt_pk_bf16(h[0], h[1]); w.y = cvt_pk_bf16(h[2], h[3]); w.z = cvt_pk_bf16(h[4], h[5]); w.w = cvt_pk_bf16(h[6], h[7]);
                *(u32x4*)(Hb + (size_t)(row0 + ai * HALF + m * 16) * ldh + col0) = w; }
    }
};
struct EpiSwiGLU8 {
    static constexpr bool PERM = true;
    fp8* Hq; int ldh; float s;
    __device__ __forceinline__ void operator()(const f32x4 (&acc)[2][2][4][2], const Unit& u, int wr, int wc, int fr, int fq) const {
        const int row0 = u.pm * BM + wr * 64 + fr, col0 = u.pn * HALF + wc * 32 + 8 * fq;
#pragma unroll
        for (int ai = 0; ai < 2; ++ai)
#pragma unroll
            for (int m = 0; m < 4; ++m) { float h[8];
#pragma unroll
                for (int n = 0; n < 2; ++n)
#pragma unroll
                    for (int jp = 0; jp < 2; ++jp) {
                        const f32x2 g2 = {acc[ai][0][m][n][2 * jp], acc[ai][0][m][n][2 * jp + 1]}, u2 = {acc[ai][1][m][n][2 * jp], acc[ai][1][m][n][2 * jp + 1]};
                        const f32x2 t2 = g2 * (-1.4426950408889634f * s);
                        f32x2 e2; e2.x = __builtin_amdgcn_exp2f(t2.x); e2.y = __builtin_amdgcn_exp2f(t2.y);
                        const f32x2 d2 = e2 + 1.0f;
                        f32x2 r2; r2.x = __builtin_amdgcn_rcpf(d2.x); r2.y = __builtin_amdgcn_rcpf(d2.y);
                        const f32x2 h2 = ((g2 * u2) * r2) * (s * s);
                        h[n * 4 + 2 * jp] = h2.x; h[n * 4 + 2 * jp + 1] = h2.y; }
                u32x2 w; w.x = pk4_fp8(h[0], h[1], h[2], h[3]); w.y = pk4_fp8(h[4], h[5], h[6], h[7]);
                *(u32x2*)(Hq + (size_t)(row0 + ai * HALF + m * 16) * ldh + col0) = w; }
    }
};
struct EpiBf16S {
    static constexpr bool PERM = true;
    bf16* O; int ldc; float s;
    __device__ __forceinline__ void operator()(const f32x4 (&acc)[2][2][4][2], const Unit& u, int wr, int wc, int fr, int fq) const {
        const int row0 = u.pm * BM + wr * 64 + fr, col0 = u.pn * BM + wc * 32 + 8 * fq;
#pragma unroll
        for (int ai = 0; ai < 2; ++ai)
#pragma unroll
            for (int m = 0; m < 4; ++m) { bf16* rowp = O + (size_t)(row0 + ai * HALF + m * 16) * ldc + col0;
#pragma unroll
                for (int bj = 0; bj < 2; ++bj) { const f32x4 v0 = acc[ai][bj][m][0] * s, v1 = acc[ai][bj][m][1] * s;
                    u32x4 w; w.x = cvt_pk_bf16(v0[0], v0[1]); w.y = cvt_pk_bf16(v0[2], v0[3]); w.z = cvt_pk_bf16(v1[0], v1[1]); w.w = cvt_pk_bf16(v1[2], v1[3]);
                    *(u32x4*)(rowp + bj * HALF) = w; } }
    }
};
struct EpiQkvaPrep {
    static constexpr bool PERM = false, AFTER_DRAIN = true;
    bf16* cqkv; bf16* krope; const float* qnorm; const float* kvnorm; const float* cosT; const float* sinT;
    __device__ __forceinline__ void operator()(const f32x4 (&)[2][2][4][2], const Unit&, int, int, int, int) const {}
    __device__ __forceinline__ void after(const f32x4 (&acc)[2][2][4][2], const Unit& u, int wr, int wc, int fr, int fq, LAS unsigned char* lds, int lane) const {
        LAS float* P = (LAS float*)lds;
        LAS float* RT = (LAS float*)(lds + 4096);
        const bool t1 = u.pn == 1; (void)lane;
#pragma unroll
        for (int ai = 0; ai < 2; ++ai)
#pragma unroll
            for (int m = 0; m < 4; ++m) { const int row = ai * HALF + wr * 64 + m * 16 + fr; float s = 0.f;
#pragma unroll
                for (int n = 0; n < 2; ++n) { const f32x4 a = acc[ai][0][m][n], b = acc[ai][1][m][n]; s += (a[0] * a[0] + a[1] * a[1]) + (a[2] * a[2] + a[3] * a[3]);
                    if (!t1) s += (b[0] * b[0] + b[1] * b[1]) + (b[2] * b[2] + b[3] * b[3]);
                    else if (wc < 2) *(LAS f32x4*)(RT + row * 64 + 32 * wc + 16 * n + 4 * fq) = b; }
                s += __shfl_xor(s, 16); s += __shfl_xor(s, 32);
                if (fq == 0) P[row * 4 + wc] = s; }
        asm volatile("s_waitcnt lgkmcnt(0)" ::: "memory"); __builtin_amdgcn_s_barrier(); asm volatile("" ::: "memory");
        const float* gn = t1 ? kvnorm : qnorm; const float inv_n = t1 ? (1.f / KVL) : (1.f / QL);
        f32x4 g[2][2];
#pragma unroll
        for (int bj = 0; bj < 2; ++bj)
#pragma unroll
            for (int n = 0; n < 2; ++n) g[bj][n] = (t1 && bj == 1) ? (f32x4){0.f, 0.f, 0.f, 0.f} : *(const f32x4*)(gn + bj * HALF + wc * 32 + n * 16 + 4 * fq);
#pragma unroll
        for (int ai = 0; ai < 2; ++ai)
#pragma unroll
            for (int m = 0; m < 4; ++m) { const int row = ai * HALF + wr * 64 + m * 16 + fr; const size_t grow = (size_t)u.pm * BM + row;
                const f32x4 pp = *(const LAS f32x4*)(P + row * 4); const float rstd = 1.f / sqrtf(((pp[0] + pp[1]) + (pp[2] + pp[3])) * inv_n + RMS_EPS);
                bf16* crow = cqkv + grow * QKVB_K + (t1 ? QL : 0) + wc * 32 + 4 * fq;
#pragma unroll
                for (int n = 0; n < 2; ++n) { const f32x4 a = acc[ai][0][m][n] * rstd * g[0][n]; u32x2 w; w.x = cvt_pk_bf16(a[0], a[1]); w.y = cvt_pk_bf16(a[2], a[3]); *(u32x2*)(crow + n * 16) = w;
                    if (!t1) { const f32x4 b = acc[ai][1][m][n] * rstd * g[1][n]; u32x2 w2; w2.x = cvt_pk_bf16(b[0], b[1]); w2.y = cvt_pk_bf16(b[2], b[3]); *(u32x2*)(crow + HALF + n * 16) = w2; }
                    else if (wc < 2) { const int i0 = 16 * n + 4 * fq, pos = (int)(grow & (SEQ - 1)); const f32x4 cs = *(const f32x4*)(cosT + pos * 32 + i0), sn = *(const f32x4*)(sinT + pos * 32 + i0);
                        const f32x4 mine = acc[ai][1][m][n], other = *(const LAS f32x4*)(RT + row * 64 + 32 * (1 - wc) + i0);
                        const f32x4 o = (wc == 0) ? (mine * cs - other * sn) : (other * sn + mine * cs);
                        u32x2 w3; w3.x = cvt_pk_bf16(o[0], o[1]); w3.y = cvt_pk_bf16(o[2], o[3]); *(u32x2*)(krope + grow * 64 + 32 * wc + i0) = w3; } } }
    }
};
struct EpiBf16 {
    static constexpr bool PERM = true;
    bf16* O; int ldc;
    __device__ __forceinline__ void operator()(const f32x4 (&acc)[2][2][4][2], const Unit& u, int wr, int wc, int fr, int fq) const {
        const int row0 = u.pm * BM + wr * 64 + fr, col0 = u.pn * BM + wc * 32 + 8 * fq;
#pragma unroll
        for (int ai = 0; ai < 2; ++ai)
#pragma unroll
            for (int m = 0; m < 4; ++m) { bf16* rowp = O + (size_t)(row0 + ai * HALF + m * 16) * ldc + col0;
#pragma unroll
                for (int bj = 0; bj < 2; ++bj) { const f32x4 v0 = acc[ai][bj][m][0], v1 = acc[ai][bj][m][1];
                    u32x4 w; w.x = cvt_pk_bf16(v0[0], v0[1]); w.y = cvt_pk_bf16(v0[2], v0[3]); w.z = cvt_pk_bf16(v1[0], v1[1]); w.w = cvt_pk_bf16(v1[2], v1[3]);
                    *(u32x4*)(rowp + bj * HALF) = w; } }
    }
};
}

namespace att {
constexpr int KVBLK = 64, QBLK = 32, QB = 256;
constexpr int SHM_V = KVBLK * 128 * 2, SHM_K = KVBLK * 128 * 2, SHM_R = KVBLK * 64 * 2;
constexpr int OFF_V = 0, OFF_K = 2 * SHM_V, OFF_R = OFF_K + 2 * SHM_K, OFF_WS = OFF_R + 2 * SHM_R, ATT_LDS = OFF_WS + 8 * 64 * 4;
constexpr float SCALE = 0.07216878364870322f;
constexpr float THR = 8.f;
#define KSWZ(row, colB) ((row) * 256 + ((colB) ^ (((row) & 7) << 4)))
#define RSWZ(row, colB) ((row) * 128 + ((colB) ^ (((row) & 7) << 4)))
#define SBAR() __builtin_amdgcn_sched_barrier(0)
__device__ __forceinline__ int v_st(int k, int c) { const int kk = (k & ~0xC) | ((k & 4) << 1) | ((k & 8) >> 1); return ((kk >> 3) * 4 + (c >> 5)) * 512 + ((kk & 7) * 32 + (c & 31)) * 2; }
__device__ __forceinline__ int v_rd_base(int lane) { return ((lane & 3) << 3) | (((lane >> 2) & 3) << 6) | (((lane >> 4) & 1) << 5) | (((lane >> 5) & 1) << 8); }
constexpr int v_rd_off(int d0, int ks, int half) { return d0 * 512 + ks * 4096 + half * 2048; }
__device__ __forceinline__ int crow(int r, int hi) { return (r & 3) + 8 * (r >> 2) + 4 * hi; }
__device__ __forceinline__ void mask_tile(f32x16& p0, f32x16& p1, int dq) {
    const float NEG = -__builtin_inff();
#pragma unroll
    for (int r = 0; r < 16; ++r) {
        const int c = (r & 3) + 8 * (r >> 2);
        if (dq - c < 0) p0[r] = NEG;
        if (dq - c - 32 < 0) p1[r] = NEG;
    }
}
__device__ __forceinline__ void partialSM(f32x16& p0, f32x16& p1, float& m_reg, float& mn, float& alpha) {
    float pmax = p0[0];
#pragma unroll
    for (int r = 1; r < 16; ++r) pmax = fmaxf(pmax, p0[r]);
#pragma unroll
    for (int r = 0; r < 16; ++r) pmax = fmaxf(pmax, p1[r]);
    { auto rr = __builtin_amdgcn_permlane32_swap(__float_as_uint(pmax), __float_as_uint(pmax), false, false);
      pmax = fmaxf(__uint_as_float(rr[0]), __uint_as_float(rr[1])); }
    constexpr float C2 = 1.4426950408889634f * SCALE;
    if (__builtin_expect(__all((pmax - m_reg) * SCALE <= THR), 1)) { mn = m_reg; alpha = 1.f; }
    else { mn = fmaxf(m_reg, pmax); alpha = __builtin_amdgcn_exp2f((m_reg - mn) * C2); m_reg = mn; }
    const float mnL = -mn * C2;
#pragma unroll
    for (int r = 0; r < 16; ++r) p0[r] = __builtin_amdgcn_exp2f(fmaf(p0[r], C2, mnL));
#pragma unroll
    for (int r = 0; r < 16; ++r) p1[r] = __builtin_amdgcn_exp2f(fmaf(p1[r], C2, mnL));
}
__device__ __forceinline__ void finishSM(f32x16& p0, f32x16& p1, float alpha, float& l_reg, bf16x8& pa0, bf16x8& pa1, bf16x8& pa2, bf16x8& pa3) {
    float ps = 0;
#pragma unroll
    for (int r = 0; r < 16; ++r) ps += p0[r];
#pragma unroll
    for (int r = 0; r < 16; ++r) ps += p1[r];
    { auto rr = __builtin_amdgcn_permlane32_swap(__float_as_uint(ps), __float_as_uint(ps), false, false);
      ps = __uint_as_float(rr[0]) + __uint_as_float(rr[1]); }
    l_reg = l_reg * alpha + ps;
#define PK4(P, B_, OUT) do { unsigned a0 = cvt_pk_bf16(P[B_+0], P[B_+1]), a1 = cvt_pk_bf16(P[B_+2], P[B_+3]);                          \
        unsigned b0 = cvt_pk_bf16(P[B_+4], P[B_+5]), b1 = cvt_pk_bf16(P[B_+6], P[B_+7]);                                             \
        auto r0 = __builtin_amdgcn_permlane32_swap(a0, b0, false, false); auto r1 = __builtin_amdgcn_permlane32_swap(a1, b1, false, false); \
        u32x4 w = {r0[0], r1[0], r0[1], r1[1]}; OUT = *reinterpret_cast<bf16x8*>(&w); } while (0)
    PK4(p0, 0, pa0); PK4(p0, 8, pa1); PK4(p1, 0, pa2); PK4(p1, 8, pa3);
#undef PK4
}
template <int KB>
__device__ __forceinline__ void qkt(f32x16& p0, f32x16& p1, const char* lds, int r32, int hi, const bf16x8* qr) {
    p0 = f32x16{}; p1 = f32x16{};
    const char* kb[4]; const char* kr[4];
#pragma unroll
    for (int dd = 0; dd < 4; ++dd) { kb[dd] = lds + OFF_K + KB * SHM_K + KSWZ(r32, (dd * 16 + hi * 8) * 2); kr[dd] = lds + OFF_R + KB * SHM_R + RSWZ(r32, (dd * 16 + hi * 8) * 2); }
#pragma unroll
    for (int d0 = 0; d0 < 8; ++d0) { const char* a = kb[d0 & 3] + (d0 >> 2) * 128;
        bf16x8 b0 = *reinterpret_cast<const bf16x8*>(a);
        bf16x8 b1 = *reinterpret_cast<const bf16x8*>(a + 32 * 256);
        p0 = __builtin_amdgcn_mfma_f32_32x32x16_bf16(b0, qr[d0], p0, 0, 0, 0);
        p1 = __builtin_amdgcn_mfma_f32_32x32x16_bf16(b1, qr[d0], p1, 0, 0, 0); }
#pragma unroll
    for (int d0 = 0; d0 < 4; ++d0) { const char* a = kr[d0];
        bf16x8 b0 = *reinterpret_cast<const bf16x8*>(a);
        bf16x8 b1 = *reinterpret_cast<const bf16x8*>(a + 32 * 128);
        p0 = __builtin_amdgcn_mfma_f32_32x32x16_bf16(b0, qr[8 + d0], p0, 0, 0, 0);
        p1 = __builtin_amdgcn_mfma_f32_32x32x16_bf16(b1, qr[8 + d0], p1, 0, 0, 0); }
}
template <int VB>
__device__ __forceinline__ void pv_tile(f32x16* o, int vb0, bf16x8 pa0, bf16x8 pa1, bf16x8 pa2, bf16x8 pa3) {
#define TRRD(dst, off) asm volatile("ds_read_b64_tr_b16 %0, %1 offset:%2" : "=&v"(dst) : "v"(vb0), "i"(off) : "memory")
#define PV_D0(d0) do { s16x4 l0, l1, l2, l3, h0, h1, h2, h3; constexpr int b_ = OFF_V + VB * SHM_V + v_rd_off(d0, 0, 0); \
        TRRD(l0, b_); TRRD(h0, b_ + 2048); TRRD(l1, b_ + 4096); TRRD(h1, b_ + 6144); TRRD(l2, b_ + 8192); TRRD(h2, b_ + 10240); TRRD(l3, b_ + 12288); TRRD(h3, b_ + 14336); \
        asm volatile("s_waitcnt lgkmcnt(0)" ::: "memory"); SBAR();   \
        o[d0] = __builtin_amdgcn_mfma_f32_32x32x16_bf16(pa0, (bf16x8){l0[0], l0[1], l0[2], l0[3], h0[0], h0[1], h0[2], h0[3]}, o[d0], 0, 0, 0);   \
        o[d0] = __builtin_amdgcn_mfma_f32_32x32x16_bf16(pa1, (bf16x8){l1[0], l1[1], l1[2], l1[3], h1[0], h1[1], h1[2], h1[3]}, o[d0], 0, 0, 0);   \
        o[d0] = __builtin_amdgcn_mfma_f32_32x32x16_bf16(pa2, (bf16x8){l2[0], l2[1], l2[2], l2[3], h2[0], h2[1], h2[2], h2[3]}, o[d0], 0, 0, 0);   \
        o[d0] = __builtin_amdgcn_mfma_f32_32x32x16_bf16(pa3, (bf16x8){l3[0], l3[1], l3[2], l3[3], h3[0], h3[1], h3[2], h3[3]}, o[d0], 0, 0, 0); } while (0)
    PV_D0(0); PV_D0(1); PV_D0(2); PV_D0(3);
#undef PV_D0
#undef TRRD
}
constexpr int OFF_CONV = 86016, CONV_BUF = 16384  , CONV_NB = 2 * EXD / 32  , CONV_KSTRIDE = 128 * 2 * EXD * 4  ;
struct Conv { const float* src; unsigned char* dst; int cs, G, bx, cb, pend; };
struct ConvLane { unsigned voff0, voff1, ldsE, ldsO, dstoff, sel; };
__device__ __forceinline__ ConvLane conv_lane(int wid, int lane) {
    ConvLane cl; const int kg = lane & 15, q = lane >> 4, hh = (lane >> 3) & 1;
    cl.voff0 = (unsigned)(((wid * 16 + (lane >> 3)) * (2 * EXD) + (((lane & 7) ^ ((wid * 2) & 7)) * 4)) * 4);
    cl.voff1 = (unsigned)(((wid * 16 + 8 + (lane >> 3)) * (2 * EXD) + (((lane & 7) ^ ((wid * 2 + 1) & 7)) * 4)) * 4);
    const int base = OFF_CONV + kg * 1024 + ((wid ^ (kg & 7)) * 16) + q * 4;
    cl.ldsE = (unsigned)(base + hh * 128); cl.ldsO = (unsigned)(base - hh * 128);
    cl.dstoff = (unsigned)((4 * wid + q) * D + 8 * kg);
    cl.sel = hh ? 0x02030001u : 0x03020100u;
    asm volatile("" : "+v"(cl.voff0), "+v"(cl.voff1), "+v"(cl.ldsE), "+v"(cl.ldsO), "+v"(cl.dstoff), "+v"(cl.sel));
    return cl;
}
__device__ __forceinline__ bool conv_valid(const Conv& cv, int q) { return cv.bx + (q >> 6) * cv.G < CONV_NB; }
__device__ __forceinline__ void conv_issue(const Conv& cv, const ConvLane& cl, int q, int buf, LAS unsigned char* ldsl, int wid) {
    const unsigned nbi = (unsigned)(cv.bx + (q >> 6) * cv.G), sk = (unsigned)(q & 63);
    const char* s0 = (const char*)cv.src + ((size_t)sk * CONV_KSTRIDE + nbi * 128);
    __builtin_amdgcn_global_load_lds((const unsigned*)(s0 + cl.voff0), (LAS unsigned*)(ldsl + OFF_CONV + buf * CONV_BUF + wid * 2048), 16, 0, 2);
    __builtin_amdgcn_global_load_lds((const unsigned*)(s0 + cl.voff1), (LAS unsigned*)(ldsl + OFF_CONV + buf * CONV_BUF + wid * 2048 + 1024), 16, 0, 2);
}
struct ConvRegs { float a0, a1, a2, a3, b0, b1, b2, b3; };
__device__ __forceinline__ void conv_load(ConvRegs& r, const ConvLane& cl, int buf, LAS unsigned char* ldsl) {
    const LAS float* pE = (const LAS float*)(ldsl + buf * CONV_BUF + cl.ldsE); const LAS float* pO = (const LAS float*)(ldsl + buf * CONV_BUF + cl.ldsO);
    r.a0 = pE[0]; r.a1 = pE[64]; r.a2 = pE[128]; r.a3 = pE[192]; r.b0 = pO[32]; r.b1 = pO[96]; r.b2 = pO[160]; r.b3 = pO[224];
}
__device__ __forceinline__ void conv_finish(const ConvRegs& r, const Conv& cv, const ConvLane& cl, int q) {
    const unsigned nbi = (unsigned)(cv.bx + (q >> 6) * cv.G), sk = (unsigned)(q & 63);
    const unsigned n0 = nbi * 32, up = (n0 >= (unsigned)EXD) ? 1u : 0u, n1 = n0 - up * EXD, drow0 = (n1 >> 7) * 256 + (n1 & 127) + up * 128;
    const unsigned lo = pk4_fp8(r.a0 * MOE_SC_IN, r.b0 * MOE_SC_IN, r.a1 * MOE_SC_IN, r.b1 * MOE_SC_IN), hi2 = pk4_fp8(r.a2 * MOE_SC_IN, r.b2 * MOE_SC_IN, r.a3 * MOE_SC_IN, r.b3 * MOE_SC_IN);
    u32x2 o; o.x = __builtin_amdgcn_perm(lo, lo, cl.sel); o.y = __builtin_amdgcn_perm(hi2, hi2, cl.sel);
    unsigned char* d0 = cv.dst + ((size_t)(sk >> 3) * ((size_t)2 * EXD * D) + (size_t)drow0 * D + (sk & 7) * 128);
    __builtin_nontemporal_store(o, (GAS u32x2*)(d0 + cl.dstoff));
}
__device__ __forceinline__ void conv_tail(const ConvRegs& r, bool have, Conv& cv, const ConvLane& cl, LAS unsigned char* ldsl, int wid) {
    if (have) conv_finish(r, cv, cl, cv.cs);
    const int nb = (cv.cb == 0) ? 2 : cv.cb - 1;
    cv.pend = conv_valid(cv, cv.cs + 2) ? 1 : 0;
    if (cv.pend) conv_issue(cv, cl, cv.cs + 2, nb, ldsl, wid);
    ++cv.cs; cv.cb = (cv.cb == 2) ? 0 : cv.cb + 1;
}
__device__ __forceinline__ void conv_drain(Conv& cv, LAS unsigned char* ldsl) {
    int tid_ = threadIdx.x; asm volatile("" : "+v"(tid_));
    const int wid = __builtin_amdgcn_readfirstlane(tid_ >> 6), lane = tid_ & 63;
    const ConvLane cl = conv_lane(wid, lane);
    while (conv_valid(cv, cv.cs)) { asm volatile("s_waitcnt vmcnt(0)" ::: "memory"); __syncthreads(); ConvRegs r; conv_load(r, cl, cv.cb, ldsl); conv_tail(r, true, cv, cl, ldsl, wid); }
}
template <int QP, int KP>
__device__ __forceinline__ void attn_block(const bf16* Qp, const bf16* Kp, const bf16* Vp, const bf16* Rp, bf16* Op, int P0, const float* cosT, const float* sinT, char* lds, LAS unsigned char* ldsl, Conv& cv) {
    int tid_ = threadIdx.x; asm volatile("" : "+v"(tid_));
    const int tid = tid_, wid = __builtin_amdgcn_readfirstlane(tid >> 6), lane = tid & 63, r32 = lane & 31, hi = lane >> 5;
    const int NT = (P0 + QB) / KVBLK;
    const int qlo = P0 + wid * QBLK, qm = qlo + r32 - 4 * hi;
    float* wsf = (float*)(lds + OFF_WS) + wid * 64; float* li_l = wsf; float* al_l = wsf + 32;
        const int vb0 = (int)(uintptr_t)lds + v_rd_base(lane);
    bf16x8 qr[12];
    { const bf16* qrow = Qp + (size_t)(wid * QBLK + r32) * QP + hi * 8;
#pragma unroll
      for (int d0 = 0; d0 < 12; ++d0) qr[d0] = *reinterpret_cast<const bf16x8*>(qrow + d0 * 16);
      const float* cr = cosT + (size_t)(qlo + r32) * 32 + hi * 8; const float* sn = sinT + (size_t)(qlo + r32) * 32 + hi * 8;
#pragma unroll
      for (int x = 0; x < 2; ++x) { const f32x4 c0 = *(const f32x4*)(cr + x * 16), c1 = *(const f32x4*)(cr + x * 16 + 4), s0 = *(const f32x4*)(sn + x * 16), s1 = *(const f32x4*)(sn + x * 16 + 4);
          const u32x4 a = *reinterpret_cast<const u32x4*>(&qr[8 + x]), b = *reinterpret_cast<const u32x4*>(&qr[10 + x]); u32x4 oa, ob;
#pragma unroll
          for (int e = 0; e < 4; ++e) { const float t1l = bf_lo(a[e]), t1h = bf_hi(a[e]), t2l = bf_lo(b[e]), t2h = bf_hi(b[e]);
              const float cl = (e < 2) ? c0[2 * e] : c1[2 * e - 4], ch = (e < 2) ? c0[2 * e + 1] : c1[2 * e - 3], sl = (e < 2) ? s0[2 * e] : s1[2 * e - 4], sh = (e < 2) ? s0[2 * e + 1] : s1[2 * e - 3];
              oa[e] = cvt_pk_bf16(t1l * cl - t2l * sl, t1h * ch - t2h * sh); ob[e] = cvt_pk_bf16(t1l * sl + t2l * cl, t1h * sh + t2h * ch); }
          qr[8 + x] = *reinterpret_cast<const bf16x8*>(&oa); qr[10 + x] = *reinterpret_cast<const bf16x8*>(&ob); } }
    float m_reg = -1e30f, l_reg = 0; f32x16 o[4] = {};
    int kofs, vofs, rofs;
    { const int L = wid * 1024 + lane * 16;
        { const int row = L >> 8, colB = (L & 255) ^ ((row & 7) << 4); kofs = row * KP + (colB >> 1); }
        { const int sub = L >> 9, kkh = sub >> 2, cblk = sub & 3, w = (L & 511) >> 1, kk = kkh * 8 + (w >> 5), k = (kk & ~0xC) | ((kk & 4) << 1) | ((kk & 8) >> 1); vofs = k * KP + cblk * 32 + (w & 31); }
        { const int row = L >> 7, colB = (L & 127) ^ ((row & 7) << 4); rofs = row * 64 + (colB >> 1); } }
#define SLOAD(k0, bf) do { \
        __builtin_amdgcn_global_load_lds((const unsigned*)(Kp + (size_t)(k0) * KP + kofs), (LAS unsigned*)(ldsl + OFF_K + (bf) * SHM_K + wid * 1024), 16, 0, 0); \
        __builtin_amdgcn_global_load_lds((const unsigned*)(Kp + (size_t)((k0) + 32) * KP + kofs), (LAS unsigned*)(ldsl + OFF_K + (bf) * SHM_K + 8192 + wid * 1024), 16, 0, 0); \
        __builtin_amdgcn_global_load_lds((const unsigned*)(Vp + (size_t)(k0) * KP + vofs), (LAS unsigned*)(ldsl + OFF_V + (bf) * SHM_V + wid * 1024), 16, 0, 0); \
        __builtin_amdgcn_global_load_lds((const unsigned*)(Vp + (size_t)((k0) + 32) * KP + vofs), (LAS unsigned*)(ldsl + OFF_V + (bf) * SHM_V + 8192 + wid * 1024), 16, 0, 0); \
        __builtin_amdgcn_global_load_lds((const unsigned*)(Rp + (size_t)(k0) * 64 + rofs), (LAS unsigned*)(ldsl + OFF_R + (bf) * SHM_R + wid * 1024), 16, 0, 0); } while (0)
#define RESC(a) do { if (__any((a) < 1.f)) { if (hi == 0) al_l[r32] = (a); asm volatile("s_waitcnt lgkmcnt(0)" ::: "memory");              \
                     for (int d_ = 0; d_ < 4; ++d_) for (int r = 0; r < 16; ++r) o[d_][r] *= al_l[crow(r, hi)]; } } while (0)
#define STEP(t, BF) do { const int kb_ = (t) * KVBLK;                                                                            \
        if (CONV_IN_ATTN && (t) > 0 && cv.pend) asm volatile("s_waitcnt vmcnt(2)" ::: "memory"); else asm volatile("s_waitcnt vmcnt(0)" ::: "memory");       \
        asm volatile("s_waitcnt lgkmcnt(0)" ::: "memory"); __builtin_amdgcn_s_barrier(); asm volatile("" ::: "memory");     \
        if ((t) + 1 < NT) SLOAD(kb_ + KVBLK, 1 - (BF));                                                                         \
        const bool chave_ = CONV_IN_ATTN && conv_valid(cv, cv.cs);                                                                \
        if (kb_ <= qlo + QBLK - 1) { f32x16 p0, p1; float mn, al; bf16x8 pa0, pa1, pa2, pa3;                                     \
            qkt<BF>(p0, p1, lds, r32, hi, qr);                                                                                   \
            if (kb_ + KVBLK - 1 > qlo) mask_tile(p0, p1, qm - kb_);                                                              \
            partialSM(p0, p1, m_reg, mn, al); RESC(al);                                                                          \
            finishSM(p0, p1, al, l_reg, pa0, pa1, pa2, pa3); SBAR();                                                             \
            pv_tile<BF>(o, vb0, pa0, pa1, pa2, pa3); }                                                                           \
        if (CONV_IN_ATTN) { ConvRegs cr_; if (chave_) conv_load(cr_, cl, cv.cb, ldsl); conv_tail(cr_, chave_, cv, cl, ldsl, wid); } } while (0)
    __syncthreads();
    SLOAD(0, 0);
    const ConvLane cl = conv_lane(wid, lane);
    if (CONV_IN_ATTN && cv.cs == 0) { if (conv_valid(cv, 0)) conv_issue(cv, cl, 0, 0, ldsl, wid); if (conv_valid(cv, 1)) conv_issue(cv, cl, 1, 1, ldsl, wid); }
    for (int t = 0; t < NT; t += 2) { STEP(t, 0); STEP(t + 1, 1); }
    if (hi == 0) li_l[r32] = l_reg; asm volatile("s_waitcnt lgkmcnt(0)" ::: "memory");
    bf16* Ow = Op + (size_t)(wid * QBLK) * D;
#pragma unroll
    for (int r = 0; r < 16; ++r) { const int orow = crow(r, hi); const float rl = __builtin_amdgcn_rcpf(li_l[orow]);
#pragma unroll
        for (int d0 = 0; d0 < 4; ++d0) { const float v = o[d0][r] * rl; const float vn = __shfl_xor(v, 1);
            if ((r32 & 1) == 0) *(unsigned*)(Ow + (size_t)orow * D + d0 * 32 + r32) = cvt_pk_bf16(v, vn); } }
#undef SLOAD
#undef RESC
#undef STEP
}
}

#define XB_TMO      128
#define XB_XCNT(j)  (256  + 64 * (j))
#define XB_XSUB(j)  (1280 + 64 * (j))
#define XB_XGEN(j)  (2304 + 64 * (j))
#define XB_TOP      3328
#define XB_TOPGEN   3392
#define XCD_BAR_WORDS 3456
#define XB_SPIN_CAP (1u << 22)
__device__ __forceinline__ unsigned xb_ld(unsigned* p)              { return __hip_atomic_load(p, __ATOMIC_RELAXED, __HIP_MEMORY_SCOPE_AGENT); }
__device__ __forceinline__ unsigned xb_add(unsigned* p, unsigned v) { return __hip_atomic_fetch_add(p, v, __ATOMIC_RELAXED, __HIP_MEMORY_SCOPE_AGENT); }
__device__ __forceinline__ unsigned xb_xcc_id() { return (unsigned)__builtin_amdgcn_s_getreg((3 << 11) | 20) & 0xFu; }
#define XB_SPIN(cond, bar) do { unsigned _sp = 0; while (cond) { __builtin_amdgcn_s_sleep(1); \
    if ((++_sp & 255u) == 0u) { if (xb_ld(&(bar)[XB_TMO])) break; if (_sp > XB_SPIN_CAP) { atomicAdd(&(bar)[XB_TMO], 1u); break; } } } } while (0)
struct XcdBarrier { unsigned* bar; unsigned x; volatile LAS unsigned* st; };
__device__ __forceinline__ XcdBarrier xcd_barrier_post(unsigned* bar, volatile LAS unsigned* st) {
    XcdBarrier b; b.bar = bar; b.x = xb_xcc_id(); b.st = st;
    if (threadIdx.x == 0) (void)xb_add(&bar[XB_XCNT(b.x)], 1u);
    return b;
}
__device__ __forceinline__ void xcd_barrier_complete(unsigned* bar, unsigned x, unsigned& nloc, unsigned& nx) {
    const unsigned G = gridDim.x * gridDim.y * gridDim.z;
    unsigned sum, cnt, mine, sp = 0u;
    for (;;) {
        sum = 0u; cnt = 0u; mine = 0u;
#pragma unroll
        for (unsigned j = 0; j < 16; ++j) { const unsigned c = xb_ld(&bar[XB_XCNT(j)]); sum += c; cnt += (c > 0u) ? 1u : 0u; mine = (j == x) ? c : mine; }
        if (sum == G) break;
        __builtin_amdgcn_s_sleep(1);
        if ((++sp & 255u) == 0u) { if (xb_ld(&bar[XB_TMO])) break; if (sp > XB_SPIN_CAP) { atomicAdd(&bar[XB_TMO], 1u); break; } }
    }
    nloc = mine > 0u ? mine : 1u; nx = cnt > 0u ? cnt : 1u;
}
__device__ __forceinline__ void xcd_barrier(const XcdBarrier& b) {
    asm volatile("s_waitcnt vmcnt(0)" ::: "memory");
    __syncthreads();
    if (threadIdx.x == 0) {
        unsigned* bar = b.bar;
        __builtin_amdgcn_s_waitcnt(0);
        unsigned nloc = b.st[0], nx = b.st[1];
        if (nloc == 0u) { xcd_barrier_complete(bar, b.x, nloc, nx); b.st[0] = nloc; b.st[1] = nx; }
        const unsigned old = xb_add(&bar[XB_XSUB(b.x)], 1u);
        const unsigned gen = old / nloc;
        if (old + 1u == (gen + 1u) * nloc) {
            __builtin_amdgcn_fence(__ATOMIC_RELEASE, "agent");
            asm volatile("s_waitcnt vmcnt(0)" ::: "memory");
            const unsigned og = xb_add(&bar[XB_TOP], 1u);
            const unsigned tg = og / nx;
            if (og + 1u == (tg + 1u) * nx) xb_add(&bar[XB_TOPGEN], 1u);
            else XB_SPIN(xb_ld(&bar[XB_TOPGEN]) == tg, bar);
            __builtin_amdgcn_fence(__ATOMIC_ACQUIRE, "agent");
            xb_add(&bar[XB_XGEN(b.x)], 1u);
            asm volatile("s_waitcnt vmcnt(0)" ::: "memory");
        } else {
            XB_SPIN(xb_ld(&bar[XB_XGEN(b.x)]) == gen, bar);
            __builtin_amdgcn_fence(__ATOMIC_ACQUIRE, "agent");
            asm volatile("s_waitcnt vmcnt(0)" ::: "memory");
        }
    }
    __syncthreads();
}

struct Args { const float* in[24]; float* out; unsigned char* ws; int ph_lo, ph_hi, li, pad; };
enum In { I_X = 0, I_LAMRE, I_LAMIM, I_LOGSTEP, I_BRE, I_BIM, I_CRE, I_CIM, I_SD, I_WGLU, I_QWA, I_QNORM, I_QWB, I_OW, I_KVWA, I_KVNORM, I_KVWB, I_FFNIN, I_FFNOUT, I_ROUTER, I_MOEIN, I_MOEOUT, I_LNG, I_LNB };

__device__ __forceinline__ void tr_item(const float* W, int N, bf16* WT, int ldk, int k0, int n0, int drow0, int dk0, LAS float* scr, int lane) {
    { const int r4 = lane >> 4, c4 = (lane & 15) * 4;
      f32x4 v[16];
#pragma unroll
      for (int i = 0; i < 16; ++i) v[i] = __builtin_nontemporal_load((const GAS f32x4*)(W + (size_t)(k0 + 4 * i + r4) * N + n0 + c4));
#pragma unroll
      for (int i = 0; i < 16; ++i) { LAS float* d = scr + (4 * i + r4) * 65 + c4; d[0] = v[i][0]; d[1] = v[i][1]; d[2] = v[i][2]; d[3] = v[i][3]; } }
    LDS_WAIT(); asm volatile("" ::: "memory");
    const int c = lane & 7;
#pragma unroll
    for (int jj = 0; jj < 8; ++jj) { const int n = (lane >> 3) + 8 * jj; const LAS float* s = scr + (8 * c) * 65 + n;
        u32x4 o; o.x = cvt_pk_bf16(s[0 * 65], s[1 * 65]); o.y = cvt_pk_bf16(s[2 * 65], s[3 * 65]); o.z = cvt_pk_bf16(s[4 * 65], s[5 * 65]); o.w = cvt_pk_bf16(s[6 * 65], s[7 * 65]);
        __builtin_nontemporal_store(o, (GAS u32x4*)(WT + (size_t)(drow0 + n) * ldk + dk0 + k0 + 8 * c)); }
    LDS_WAIT(); asm volatile("" ::: "memory");
}
__device__ __forceinline__ void tr_item8(const float* W, int N, fp8* WT, int ldk, int k0, int n0, int drow0, float sc, LAS float* scr, int lane) {
    { const int r4 = lane >> 4, c4 = (lane & 15) * 4;
      f32x4 v[16];
#pragma unroll
      for (int i = 0; i < 16; ++i) v[i] = __builtin_nontemporal_load((const GAS f32x4*)(W + (size_t)(k0 + 4 * i + r4) * N + n0 + c4));
#pragma unroll
      for (int i = 0; i < 16; ++i) { LAS float* d = scr + (4 * i + r4) * 65 + c4; d[0] = v[i][0] * sc; d[1] = v[i][1] * sc; d[2] = v[i][2] * sc; d[3] = v[i][3] * sc; } }
    LDS_WAIT(); asm volatile("" ::: "memory");
    const int c = lane & 3;
#pragma unroll
    for (int jj = 0; jj < 4; ++jj) { const int n = (lane >> 2) + 16 * jj; const LAS float* s = scr + (16 * c) * 65 + n;
        u32x4 o; o.x = pk4_fp8(s[0 * 65], s[1 * 65], s[2 * 65], s[3 * 65]); o.y = pk4_fp8(s[4 * 65], s[5 * 65], s[6 * 65], s[7 * 65]);
        o.z = pk4_fp8(s[8 * 65], s[9 * 65], s[10 * 65], s[11 * 65]); o.w = pk4_fp8(s[12 * 65], s[13 * 65], s[14 * 65], s[15 * 65]);
        __builtin_nontemporal_store(o, (GAS u32x4*)(WT + (size_t)(drow0 + n) * ldk + k0 + 16 * c)); }
    LDS_WAIT(); asm volatile("" ::: "memory");
}
__device__ __forceinline__ void tr_matrix_item8(const float* W, int N, fp8* WT, int ldk, int ilv, float sc, LAS float* scr, int item, int lane) {
    const int nb = N / 64, kb = item / nb, nbi = item % nb, n0 = nbi * 64;
    int drow = n0;
    if (ilv > 0) { const int n1 = (n0 >= ilv) ? n0 - ilv : n0; drow = (n1 >> 7) * 256 + (n1 & 127) + ((n0 >= ilv) ? 128 : 0); }
    tr_item8(W, N, WT, ldk, kb * 128, n0, drow, sc, scr, lane); tr_item8(W, N, WT, ldk, kb * 128 + 64, n0, drow, sc, scr, lane);
}
__device__ __forceinline__ void tr_matrix_item(const float* W, int K, int N, bf16* WT, int ldk, int drow_base, int dk0, int ilv, LAS float* scr, int item, int lane) {
    const int nb = N / 64, kb = item / nb, nbi = item % nb, n0 = nbi * 64; (void)K;
    int drow = n0;
    if (ilv > 0) { const int n1 = (n0 >= ilv) ? n0 - ilv : n0; drow = (n1 >> 7) * 256 + (n1 & 127) + ((n0 >= ilv) ? 128 : 0); }
    tr_item(W, N, WT, ldk, kb * 64, n0, drow_base + drow, dk0, scr, lane);
}

__global__ void __launch_bounds__(NWAVES * 64, 2) yoco_fwd(Args args) {
    extern __shared__ __attribute__((aligned(16))) unsigned char lds_raw[];
    LAS unsigned char* lds = (LAS unsigned char*)lds_raw;
    volatile LAS unsigned* MISC = (volatile LAS unsigned*)(lds + MISC_OFF);
    const int G = gridDim.x; const int bx = blockIdx.x; const int vcu = (G % 8 == 0) ? (bx % 8) * (G / 8) + bx / 8 : bx;
    const int NGW = G * NWAVES;
#define PHASE_IDS() int tid = threadIdx.x; asm volatile("" : "+v"(tid)); const int lane = tid & 63, wave = __builtin_amdgcn_readfirstlane(tid >> 6); const int gw = vcu * NWAVES + wave; (void)gw; (void)lane
    unsigned char* ws = args.ws;
    GAS unsigned* ctl = (GAS unsigned*)(ws + WS_CTL);
    for (int u = threadIdx.x; u < (LDS_BYTES - LDSCTL_OFF) / 4; u += NWAVES * 64) ((LAS unsigned*)(lds + LDSCTL_OFF))[u] = 0u;
    __syncthreads();
    XcdBarrier bar; bar.bar = (unsigned*)(ws + WS_CTL) + CW_BAR; bar.x = 0; bar.st = nullptr;
    if (MK_N_LAUNCHES == 1) bar = xcd_barrier_post((unsigned*)(ws + WS_CTL) + CW_BAR, MISC + 8);
#define GRID_BAR() do { if (MK_N_LAUNCHES == 1) xcd_barrier(bar); } while (0)
    const int lo = args.ph_lo, hi_ph = args.ph_hi;
#ifndef PH_MASK
#define PH_MASK 0x3ffffff
#endif
#define IN(k) (((PH_MASK >> (k)) & 1) && lo <= (k) && (k) < hi_ph)
#define BOTH(k) (IN(k) && IN((k) + 1))

    const float* x_in = args.in[I_X];
    bf16* W_MOEIN = (bf16*)(ws + WS_MOEIN); bf16* W_MOEOUT = (bf16*)(ws + WS_MOEOUT); bf16* W_FFNIN = (bf16*)(ws + WS_FFNIN); bf16* W_FFNOUT = (bf16*)(ws + WS_FFNOUT);
    bf16* W_GLU = (bf16*)(ws + WS_GLU); bf16* W_OW = (bf16*)(ws + WS_OW); bf16* W_QKVB = (bf16*)(ws + WS_QKVB); bf16* W_QKVA = (bf16*)(ws + WS_QKVA);
    bf16* W_S5ST = (bf16*)(ws + WS_S5ST); bf16* W_S5W3 = (bf16*)(ws + WS_S5W3);
    float* ROPE_C = (float*)(ws + WS_ROPE); float* ROPE_S = ROPE_C + SEQ * 32;
    float* PTAB = (float*)(ws + WS_PTAB); float* BBTAB = (float*)(ws + WS_BBTAB);
    bf16* A3 = (bf16*)(ws + WS_A3); float* SEND = (float*)(ws + WS_SEND); bf16* ACT = (bf16*)(ws + WS_ACT); bf16* Hb = (bf16*)(ws + WS_H);
    bf16* X1 = (bf16*)(ws + WS_X1); bf16* FFNH = (bf16*)(ws + WS_FFNH); bf16* X2 = (bf16*)(ws + WS_X2); float* QKVAF = (float*)(ws + WS_QKVAF);
    bf16* CQKV = (bf16*)(ws + WS_CQKV); bf16* KROPE = (bf16*)(ws + WS_KROPE); bf16* QKV = (bf16*)(ws + WS_QKV); bf16* H3b = (bf16*)(ws + WS_H3);
    bf16* OB = (bf16*)(ws + WS_O); bf16* X3 = (bf16*)(ws + WS_X3); bf16* MOEH = (bf16*)(ws + WS_MOEH); fp8* X3Q = (fp8*)(ws + WS_MOEH + 232 * MiB); (void)X3Q; float* YSLAB = (float*)(ws + WS_MOEH + 264 * MiB); (void)YSLAB;   bf16* YB = (bf16*)(ws + WS_Y);
    int* ROW_TOK = (int*)(ws + WS_ROUTE); int* TOK_INFO = (int*)(ws + WS_ROUTE + 1 * MiB); float* GATES = (float*)(ws + WS_ROUTE + 1 * MiB + 512 * 1024);

    if (IN(0) || IN(18) || IN(19) || IN(20)) {
        PHASE_IDS();
        LAS float* scr = (LAS float*)(lds + RING_OFF + wave * 16640);
        constexpr int I_GLU = 16 * 32, I_FIN = 16 * 88, I_FOUT = (FFN_DOWN_FP8 ? 22 : 44) * 16, I_QA = 16 * 4, I_KVA = 16 * 3, I_O = MLA_ABSORB ? 0 : 16 * 16, I_QB = MLA_ABSORB ? 0 : 4 * 24, I_KVB = MLA_ABSORB ? 0 : 2 * 32, I_MIN = (MOE_FP8 ? (CONV_IN_ATTN ? 0 : 8) : 16) * 112, I_MOUT = (MOE_FP8 ? 28 : 56) * 16;
        constexpr int NITEMS = I_GLU + I_FIN + I_FOUT + I_QA + I_KVA + I_O + I_QB + I_KVB + NEXP * (I_MIN + (MOE_FP8 ? 0 : I_MOUT));
        if (IN(0) || IN(18))
        for (int it = gw; it < NITEMS; it += NGW) {
            int r = it;
            if (r < I_GLU) { tr_matrix_item(args.in[I_WGLU], D, 2 * D, W_GLU, D, 0, 0, D, scr, r, lane); continue; } r -= I_GLU;
            if (r < I_FIN) { tr_matrix_item(args.in[I_FFNIN], D, 2 * FFN, W_FFNIN, D, 0, 0, FFN, scr, r, lane); continue; } r -= I_FIN;
#if FFN_DOWN_FP8
            if (r < I_FOUT) { tr_matrix_item8(args.in[I_FFNOUT], D, (fp8*)W_FFNOUT, FFN, 0, MOE_SC_OUT, scr, r, lane); continue; } r -= I_FOUT;
#else
            if (r < I_FOUT) { tr_matrix_item(args.in[I_FFNOUT], FFN, D, W_FFNOUT, FFN, 0, 0, 0, scr, r, lane); continue; } r -= I_FOUT;
#endif
            if (r < I_QA) { tr_matrix_item(args.in[I_QWA], D, QL, W_QKVA, D, 0, 0, 0, scr, r, lane); continue; } r -= I_QA;
            if (r < I_KVA) { tr_matrix_item(args.in[I_KVWA], D, KVL + QKR, W_QKVA, D, QL, 0, 0, scr, r, lane); continue; } r -= I_KVA;
#if !MLA_ABSORB
            if (r < I_O) { tr_matrix_item(args.in[I_OW], D, D, W_OW, D, 0, 0, 0, scr, r, lane); continue; } r -= I_O;
            if (r < I_QB) { tr_matrix_item(args.in[I_QWB], QL, QW, W_QKVB, QKVB_K, 0, 0, 0, scr, r, lane); continue; } r -= I_QB;
            if (r < I_KVB) { tr_matrix_item(args.in[I_KVWB], KVL, HEADS * (QKN + VD), W_QKVB, QKVB_K, QW, QL, 0, scr, r, lane); continue; } r -= I_KVB;
#endif
#if MOE_FP8 && CONV_IN_ATTN
            (void)r;
#elif MOE_FP8
            { const int e = r / I_MIN; tr_matrix_item8(args.in[I_MOEIN] + (size_t)e * D * 2 * EXD, 2 * EXD, (fp8*)W_MOEIN + (size_t)e * 2 * EXD * D, D, EXD, MOE_SC_IN, scr, r % I_MIN, lane); }
#else
            if (r < NEXP * I_MIN) { const int e = r / I_MIN; tr_matrix_item(args.in[I_MOEIN] + (size_t)e * D * 2 * EXD, D, 2 * EXD, W_MOEIN + (size_t)e * 2 * EXD * D, D, 0, 0, EXD, scr, r % I_MIN, lane); continue; } r -= NEXP * I_MIN;
            { const int e = r / I_MOUT; tr_matrix_item(args.in[I_MOEOUT] + (size_t)e * EXD * D, EXD, D, W_MOEOUT + (size_t)e * D * EXD, EXD, 0, 0, 0, scr, r % I_MOUT, lane); }
#endif
        }
        if (IN(0) || IN(19)) { const u32x4 z = {0u, 0u, 0u, 0u}; const size_t gt = (size_t)gw * 64 + lane, GT = (size_t)NGW * 64;
          for (size_t i = gt; i < (size_t)64 * D / 8; i += GT) *(GAS u32x4*)(W_QKVA + (size_t)448 * D + i * 8) = z;
#if !MLA_ABSORB
          for (size_t i = gt; i < (size_t)QW * 16; i += GT) { const size_t row = i / 16, ch = i % 16; *(GAS u32x4*)(W_QKVB + row * QKVB_K + QL + ch * 8) = z; }
          for (size_t i = gt; i < (size_t)2048 * 32; i += GT) { const size_t row = i / 32, ch = i % 32; *(GAS u32x4*)(W_QKVB + (QW + row) * QKVB_K + ch * 8) = z; }
#endif
          for (size_t i = gt; i < (size_t)S5G * 128 * 32; i += GT) { const size_t g = i / (128 * 32), rem = i % (128 * 32); *(GAS u32x4*)(W_S5ST + (g * 256 + 128) * 256 + rem * 8) = z; } }
        if (IN(0) || IN(19))
        for (int i = gw * 64 + lane; i < SEQ * 32; i += NGW * 64) { const int pos = i >> 5, f = i & 31; const float inv = powf(10000.0f, -(float)(2 * f) / 64.0f); const float ang = (float)pos * inv; float s, c; sincosf(ang, &s, &c); ROPE_C[i] = c; ROPE_S[i] = s; }
        if (IN(0) || IN(19))
        for (int i = gw * 64 + lane; i < S5G * S5P * 16; i += NGW * 64) {
            const int k = i & 15, gn = i >> 4, g = gn >> 6, n = gn & 63;
            const float lr = args.in[I_LAMRE][gn], li = args.in[I_LAMIM][gn], dt = expf(args.in[I_LOGSTEP][g]);
            const float mag = expf(lr * dt); float sn, cs; sincosf(li * dt, &sn, &cs); const float lbr = mag * cs, lbi = mag * sn;
            const float den = lr * lr + li * li, fre = ((lbr - 1.0f) * lr + lbi * li) / den, fim = (lbi * lr - (lbr - 1.0f) * li) / den;
            float pr = 1.f, pi = 0.f, pkr = 1.f, pki = 0.f, pwr = 1.f, pwi = 0.f;
#pragma unroll
            for (int d = 1; d <= 16; ++d) { const float nr = pr * lbr - pi * lbi, ni = pr * lbi + pi * lbr; pr = nr; pi = ni; if (d == k) { pkr = pr; pki = pi; } if (d == 15 - k) { pwr = pr; pwi = pi; } }
            *(GAS f32x2*)(PTAB + ((size_t)gn * 17 + k) * 2) = (f32x2){pkr, pki};
            if (k == 15) *(GAS f32x2*)(PTAB + ((size_t)gn * 17 + 16) * 2) = (f32x2){pr, pi};
            const float* brp = args.in[I_BRE] + (size_t)gn * 16; const float* bip = args.in[I_BIM] + (size_t)gn * 16;
            float bbr[16], bbi[16];
#pragma unroll
            for (int q = 0; q < 4; ++q) { const f32x4 br = *(const GAS f32x4*)(brp + 4 * q), bi = *(const GAS f32x4*)(bip + 4 * q);
#pragma unroll
                for (int e = 0; e < 4; ++e) { bbr[4 * q + e] = fre * br[e] - fim * bi[e]; bbi[4 * q + e] = fre * bi[e] + fim * br[e]; } }
            { float mr = 0.f, mi = 0.f;
#pragma unroll
              for (int ch = 0; ch < 16; ++ch) { mr = (ch == k) ? bbr[ch] : mr; mi = (ch == k) ? bbi[ch] : mi; }
              *(GAS f32x2*)(BBTAB + ((size_t)gn * 16 + k) * 2) = (f32x2){mr, mi}; }
            bf16* wre = W_S5ST + ((size_t)g * 256 + n) * 256 + k * 16; bf16* wim = W_S5ST + ((size_t)g * 256 + 64 + n) * 256 + k * 16;
            u32x4 a0, a1, b0, b1;
#pragma unroll
            for (int e = 0; e < 4; ++e) { const int c0 = 2 * e, c1 = 2 * e + 1;
                a0[e] = cvt_pk_bf16(pwr * bbr[c0] - pwi * bbi[c0], pwr * bbr[c1] - pwi * bbi[c1]); a1[e] = cvt_pk_bf16(pwr * bbr[8 + c0] - pwi * bbi[8 + c0], pwr * bbr[8 + c1] - pwi * bbi[8 + c1]);
                b0[e] = cvt_pk_bf16(pwr * bbi[c0] + pwi * bbr[c0], pwr * bbi[c1] + pwi * bbr[c1]); b1[e] = cvt_pk_bf16(pwr * bbi[8 + c0] + pwi * bbr[8 + c0], pwr * bbi[8 + c1] + pwi * bbr[8 + c1]); }
            *(GAS u32x4*)(wre) = a0; *(GAS u32x4*)(wre + 8) = a1; *(GAS u32x4*)(wim) = b0; *(GAS u32x4*)(wim + 8) = b1;
        }
        __syncthreads();
        if (IN(0) || IN(20)) {
            LAS unsigned char* tile = lds + RING_OFF;
            f32x4 v[2][4];
#define A3_LOAD(bc_) do { _Pragma("unroll") for (int t = 0; t < 2; ++t) _Pragma("unroll") for (int q = 0; q < 4; ++q) v[t][q] = __builtin_nontemporal_load((const GAS f32x4*)(x_in + ((size_t)(bc_) * LCH + 2 * wave + t) * D + q * 256 + 4 * lane)); } while (0)
            int bc = vcu;
            if (bc < NBC) A3_LOAD(bc);
            for (; bc < NBC; bc += G) {
#pragma unroll
                for (int t = 0; t < 2; ++t)
#pragma unroll
                    for (int q = 0; q < 4; ++q) { u32x2 w; w.x = cvt_pk_bf16(v[t][q][0], v[t][q][1]); w.y = cvt_pk_bf16(v[t][q][2], v[t][q][3]); *(LAS u32x2*)(tile + (2 * wave + t) * 2080 + (q * 256 + 4 * lane) * 2) = w; }
                if (bc + G < NBC) A3_LOAD(bc + G);
                LDS_WAIT(); __builtin_amdgcn_s_barrier(); asm volatile("" ::: "memory");
                const int t32 = lane & 31, j = t32 >> 1, half = t32 & 1;
#pragma unroll
                for (int i2 = 0; i2 < 4; ++i2) { const int g = 8 * wave + 2 * i2 + (lane >> 5); const u32x4 w = *(const LAS u32x4*)(tile + j * 2080 + g * 32 + half * 16);
                    __builtin_nontemporal_store(w, (GAS u32x4*)(A3 + ((size_t)g * NBC + bc) * A3_LD + j * 16 + half * 8)); }
                LDS_WAIT(); __builtin_amdgcn_s_barrier(); asm volatile("" ::: "memory");
            }
#undef A3_LOAD
        }
        if (BOTH(0)) GRID_BAR();
    }

    if (IN(1)) {
        pg8::GroupSched S{(const char*)A3, (const char*)W_S5ST, G, bx, (size_t)NBC * A3_LD * 2, (size_t)256 * 256 * 2, (size_t)256 * A3_LD * 2, 4};
        pg8::EpiS1 E{SEND};
        pg8::gemm_phase<pg8::EpiS1, pg8::GroupSched, false>(lds + RING_OFF, 256 * 2, A3_LD * 2, S, E);
        if (BOTH(1)) GRID_BAR();
    }

    if (IN(2) || IN(21) || IN(22) || IN(23) || IN(24)) {
        PHASE_IDS();
#if MLA_ABSORB
        if (IN(2) || IN(21))
        { LAS float* TA = (LAS float*)(lds + RING_OFF); LAS float* TB = TA + 128 * 132;
          for (int it2 = vcu; it2 < 160; it2 += G) {
              const int it = it2 >> 1, half = it2 & 1;
              const bool tq = it < 16; const int h = tq ? (it >> 1) : ((it - 16) >> 3), sb = tq ? (it & 1) : ((it - 16) & 7);
              const float* srcI = tq ? args.in[I_QWB] + (size_t)(sb * 128) * QW + h * (QKN + QKR) : args.in[I_KVWB] + h * (QKN + VD) + QKN; const int pI = tq ? QW : HEADS * (QKN + VD);
#pragma unroll
              for (int q = 0; q < 8; ++q) { const int idx = tid + 512 * q, row = idx >> 5, c4 = (idx & 31) * 4; *(LAS f32x4*)(TA + row * 132 + c4) = *(const GAS f32x4*)(srcI + (size_t)row * pI + c4); }
              if (tq) { const float* srcN = args.in[I_KVWB] + (size_t)(half * 64) * (HEADS * (QKN + VD)) + h * (QKN + VD);
#pragma unroll
                  for (int q = 0; q < 4; ++q) { const int idx = tid + 512 * q, row = idx >> 5, c4 = (idx & 31) * 4; *(LAS f32x4*)(TB + row * 132 + c4) = *(const GAS f32x4*)(srcN + (size_t)row * (HEADS * (QKN + VD)) + c4); }
              } else { const float* srcN = args.in[I_OW] + (size_t)(h * VD) * D + sb * 128 + half * 64;
#pragma unroll
                  for (int q = 0; q < 4; ++q) { const int idx = tid + 512 * q, dr = idx >> 4, n4 = (idx & 15) * 4; const f32x4 v = *(const GAS f32x4*)(srcN + (size_t)dr * D + n4);
                      TB[(n4 + 0) * 132 + dr] = v[0]; TB[(n4 + 1) * 132 + dr] = v[1]; TB[(n4 + 2) * 132 + dr] = v[2]; TB[(n4 + 3) * 132 + dr] = v[3]; } }
              LDS_WAIT(); __syncthreads();
              const int r32 = lane & 31, hi = lane >> 5, iblk = wave & 3, nblk = wave >> 2;
              const LAS float* pa = TA + (iblk * 32 + r32) * 132 + 4 * hi; const LAS float* pb = TB + (nblk * 32 + r32) * 132 + 4 * hi;
              f32x16 acc = {};
#pragma unroll 4
              for (int m = 0; m < 16; ++m) { const f32x4 av = *(const LAS f32x4*)(pa + 8 * m), bv = *(const LAS f32x4*)(pb + 8 * m);
#pragma unroll
                  for (int e = 0; e < 4; ++e) acc = __builtin_amdgcn_mfma_f32_32x32x2f32(av[e], bv[e], acc, 0, 0, 0); }
              { const int ng = half * 64 + nblk * 32 + r32;
                bf16* orow = tq ? W_QKVB + (size_t)(h * (QKN + QKR) + ng) * QL + sb * 128 : W_OW + (size_t)(sb * 128 + ng) * D + h * VD;
#pragma unroll
                for (int rq = 0; rq < 4; ++rq) { u32x2 w; w.x = cvt_pk_bf16(acc[4 * rq], acc[4 * rq + 1]); w.y = cvt_pk_bf16(acc[4 * rq + 2], acc[4 * rq + 3]);
                    *(GAS u32x2*)(orow + iblk * 32 + 8 * rq + 4 * hi) = w; } }
              LDS_WAIT(); __syncthreads();
          }
          { LAS float* scr = (LAS float*)(lds + RING_OFF + wave * 16640);
            for (int it = gw; it < HEADS * 4; it += NGW) { const int h = it >> 2, kb = it & 3; tr_item(args.in[I_QWB], QW, W_QKVB, QL, kb * 64, h * (QKN + QKR) + QKN, h * (QKN + QKR) + QKN, 0, scr, lane); } }
          __syncthreads();
        }
#endif
        if (IN(2) || IN(22)) {
        { LAS float* LC = (LAS float*)(lds + RING_OFF);
          LAS float* LP = LC + 2 * 16 * 65 + 16;
          LAS float* LB = LP + 2176;
          for (int it = vcu; it < S5G * 4; it += G) {
              const int g = it >> 2, dq = it & 3;
              { const int half = tid >> 8, t = tid & 255, co_ = t >> 4, c4 = (t & 15) * 4; const f32x4 v = *(const GAS f32x4*)(args.in[half ? I_CIM : I_CRE] + (size_t)g * 1024 + t * 4);
                LAS float* dst = LC + half * (16 * 65) + co_ * 65 + c4; dst[0] = v[0]; dst[1] = v[1]; dst[2] = v[2]; dst[3] = v[3]; }
              for (int i = tid; i < 544; i += 512) *(LAS f32x4*)(LP + i * 4) = *(const GAS f32x4*)(PTAB + (size_t)g * 2176 + i * 4);
              *(LAS f32x4*)(LB + tid * 4) = *(const GAS f32x4*)(BBTAB + (size_t)g * 2048 + tid * 4);
              LDS_WAIT(); __syncthreads();
              { const int sub = tid & 3, cih = (tid >> 2) & 1, co = (tid >> 3) & 15, d = dq * 4 + (tid >> 7);
                float acc8[8];
#pragma unroll
                for (int e = 0; e < 8; ++e) acc8[e] = 0.f;
                for (int n = sub; n < 64; n += 4) {
                    const f32x2 p = *(const LAS f32x2*)(LP + (n * 17 + d) * 2);
                    const float cr = LC[co * 65 + n], ci = LC[16 * 65 + co * 65 + n], cpr = cr * p.x - ci * p.y, cpi = cr * p.y + ci * p.x;
                    const LAS float* bb = LB + (n * 16 + cih * 8) * 2;
                    const f32x4 b0 = *(const LAS f32x4*)(bb), b1 = *(const LAS f32x4*)(bb + 4), b2 = *(const LAS f32x4*)(bb + 8), b3 = *(const LAS f32x4*)(bb + 12);
                    acc8[0] += cpr * b0[0] - cpi * b0[1]; acc8[1] += cpr * b0[2] - cpi * b0[3]; acc8[2] += cpr * b1[0] - cpi * b1[1]; acc8[3] += cpr * b1[2] - cpi * b1[3];
                    acc8[4] += cpr * b2[0] - cpi * b2[1]; acc8[5] += cpr * b2[2] - cpi * b2[3]; acc8[6] += cpr * b3[0] - cpi * b3[1]; acc8[7] += cpr * b3[2] - cpi * b3[3];
                }
#pragma unroll
                for (int e = 0; e < 8; ++e) { acc8[e] += __shfl_xor(acc8[e], 1); acc8[e] += __shfl_xor(acc8[e], 2); }
                if (sub == 0) {
                    if (d == 0) { const float ds = args.in[I_SD][g * 16 + co];
#pragma unroll
                        for (int e = 0; e < 8; ++e) if (cih * 8 + e == co) acc8[e] += ds; }
                    u32x4 w; w.x = cvt_pk_bf16(acc8[0], acc8[1]); w.y = cvt_pk_bf16(acc8[2], acc8[3]); w.z = cvt_pk_bf16(acc8[4], acc8[5]); w.w = cvt_pk_bf16(acc8[6], acc8[7]);
                    const u32x4 z = {0u, 0u, 0u, 0u};
                    bf16* base = W_S5W3 + (size_t)g * 256 * A3_LD + cih * 8;
                    for (int k = 0; k + d < 16; ++k) { const int j = k + d; *(GAS u32x4*)(base + (size_t)(j * 16 + co) * A3_LD + k * 16) = w; if (d > 0) *(GAS u32x4*)(base + (size_t)(k * 16 + co) * A3_LD + j * 16) = z; }
                } }
              { const int no = tid & 7, co = (tid >> 3) & 15, j = dq * 4 + (tid >> 7), row = j * 16 + co;
                float vr[8], vi[8];
#pragma unroll
                for (int e = 0; e < 8; ++e) { const int n = no * 8 + e; const f32x2 p = *(const LAS f32x2*)(LP + (n * 17 + j + 1) * 2);
                    const float cr = LC[co * 65 + n], ci = LC[16 * 65 + co * 65 + n]; vr[e] = cr * p.x - ci * p.y; vi[e] = -(cr * p.y + ci * p.x); }
                u32x4 a, b; a.x = cvt_pk_bf16(vr[0], vr[1]); a.y = cvt_pk_bf16(vr[2], vr[3]); a.z = cvt_pk_bf16(vr[4], vr[5]); a.w = cvt_pk_bf16(vr[6], vr[7]);
                b.x = cvt_pk_bf16(vi[0], vi[1]); b.y = cvt_pk_bf16(vi[2], vi[3]); b.z = cvt_pk_bf16(vi[4], vi[5]); b.w = cvt_pk_bf16(vi[6], vi[7]);
                bf16* rp = W_S5W3 + ((size_t)g * 256 + row) * A3_LD + 256 + no * 8;
                *(GAS u32x4*)(rp) = a; *(GAS u32x4*)(rp + 64) = b; }
              LDS_WAIT(); __syncthreads();
          } }
        }
        if (IN(2) || IN(23) || IN(24)) {
#if MOE_FP8
        if (wave >= 4) {
            LAS float* scr = (LAS float*)(lds + RING_OFF + wave * 16640);
            constexpr int I_MOUT2 = 28 * 16;
            if (!IN(24))
            for (int it = vcu * 4 + (wave - 4); it < NEXP * I_MOUT2; it += G * 4) { const int e = it / I_MOUT2;
                tr_matrix_item8(args.in[I_MOEOUT] + (size_t)e * EXD * D, D, (fp8*)W_MOEOUT + (size_t)e * D * EXD, EXD, 0, MOE_SC_OUT, scr, it % I_MOUT2, lane); }
        } else
        for (int chain = vcu * 4 + wave; chain < S5G * BATCH; chain += G * 4) {
#else
        for (int chain = gw; chain < S5G * BATCH; chain += NGW) {
#endif
            const int g = chain >> 4, b = chain & 15;
            const f32x2 p16 = *(const GAS f32x2*)(PTAB + (((size_t)g * 64 + lane) * 17 + 16) * 2);
            const float* sp = SEND + ((size_t)g * NBC + b * NCHUNK) * 128 + lane; bf16* ap = A3 + ((size_t)g * NBC + b * NCHUNK) * A3_LD + 256 + lane;
            float sr_ = 0.f, si_ = 0.f;
            float er[8], ei[8], fr_[8], fi_[8];
#pragma unroll
            for (int q = 0; q < 8; ++q) { er[q] = sp[(size_t)q * 128]; ei[q] = sp[(size_t)q * 128 + 64]; }
            for (int c0 = 0; c0 < NCHUNK; c0 += 8) {
                const int cn = (c0 + 8 < NCHUNK) ? c0 + 8 : c0;
#pragma unroll
                for (int q = 0; q < 8; ++q) { fr_[q] = sp[(size_t)(cn + q) * 128]; fi_[q] = sp[(size_t)(cn + q) * 128 + 64]; }
#pragma unroll
                for (int q = 0; q < 8; ++q) { ap[(size_t)(c0 + q) * A3_LD] = (bf16)(cvt_pk_bf16(sr_, 0.f) & 0xffffu); ap[(size_t)(c0 + q) * A3_LD + 64] = (bf16)(cvt_pk_bf16(si_, 0.f) & 0xffffu);
                    const float nr = p16.x * sr_ - p16.y * si_ + er[q], ni = p16.x * si_ + p16.y * sr_ + ei[q]; sr_ = nr; si_ = ni; }
#pragma unroll
                for (int q = 0; q < 8; ++q) { er[q] = fr_[q]; ei[q] = fi_[q]; }
            }
        }
        }
        if (BOTH(2)) GRID_BAR();
    }

    if (IN(3)) {
        pg8::GroupSched S{(const char*)A3, (const char*)W_S5W3, G, bx, (size_t)NBC * A3_LD * 2, (size_t)256 * A3_LD * 2, (size_t)256 * A3_LD * 2, 6};
        pg8::EpiS3 E{ACT};
        pg8::gemm_phase<pg8::EpiS3, pg8::GroupSched, false>(lds + RING_OFF, A3_LD * 2, A3_LD * 2, S, E);
        if (BOTH(3)) GRID_BAR();
    }

    if (IN(4)) {
        pg8::DenseSched S{(const char*)ACT, (const char*)W_GLU, NTOK / 256, 2 * D / 256, G, bx, (size_t)256 * D * 2, (size_t)256 * D * 2, D / 64};
        pg8::EpiGLU E{Hb};
        pg8::gemm_phase<pg8::EpiGLU, pg8::DenseSched, false>(lds + RING_OFF, D * 2, D * 2, S, E);
        if (BOTH(4)) GRID_BAR();
    }
#define LN_ROW_STATS(v, mean, rstd) do { float s_ = 0.f; _Pragma("unroll") for (int j = 0; j < 4; ++j) s_ += (v[j][0] + v[j][1]) + (v[j][2] + v[j][3]); mean = wave_sum(s_) * (1.f / D); float s2_ = 0.f; \
        _Pragma("unroll") for (int j = 0; j < 4; ++j) { v[j] = v[j] - mean; s2_ += (v[j][0] * v[j][0] + v[j][1] * v[j][1]) + (v[j][2] * v[j][2] + v[j][3] * v[j][3]); } rstd = 1.f / sqrtf(wave_sum(s2_) * (1.f / D) + LN_EPS); } while (0)
#define LN_LOAD_F32RES(v, RES, BR, m) do { const GAS f32x4* xr_ = (const GAS f32x4*)((RES) + (size_t)(m) * D) + lane; const GAS u32x2* br_ = (const GAS u32x2*)((BR) + (size_t)(m) * D) + lane; \
        _Pragma("unroll") for (int j = 0; j < 4; ++j) { const f32x4 xa = __builtin_nontemporal_load(xr_ + 64 * j); const u32x2 ba = br_[64 * j]; \
            v[j][0] = ALPHA * xa[0] + bf_lo(ba.x); v[j][1] = ALPHA * xa[1] + bf_hi(ba.x); v[j][2] = ALPHA * xa[2] + bf_lo(ba.y); v[j][3] = ALPHA * xa[3] + bf_hi(ba.y); } } while (0)
#define LN_LOAD_BF16RES(v, RES, BR, m) do { const GAS u32x2* xr_ = (const GAS u32x2*)((RES) + (size_t)(m) * D) + lane; const GAS u32x2* br_ = (const GAS u32x2*)((BR) + (size_t)(m) * D) + lane; \
        _Pragma("unroll") for (int j = 0; j < 4; ++j) { const u32x2 xa = xr_[64 * j]; const u32x2 ba = br_[64 * j]; \
            v[j][0] = ALPHA * bf_lo(xa.x) + bf_lo(ba.x); v[j][1] = ALPHA * bf_hi(xa.x) + bf_hi(ba.x); v[j][2] = ALPHA * bf_lo(xa.y) + bf_lo(ba.y); v[j][3] = ALPHA * bf_hi(xa.y) + bf_hi(ba.y); } } while (0)
#define LN_STORE_BF16(v, rstd, DST, m) do { GAS u32x2* o8 = (GAS u32x2*)((DST) + (size_t)(m) * D) + lane; \
        _Pragma("unroll") for (int j = 0; j < 4; ++j) { const f32x4 y = v[j] * rstd * gv[j] + bv[j]; u32x2 w; w.x = cvt_pk_bf16(y[0], y[1]); w.y = cvt_pk_bf16(y[2], y[3]); o8[64 * j] = w; } } while (0)
#define LN_PHASE(LOADER, RES, BR, DST, LIDX) do { const float* gp = args.in[I_LNG] + (LIDX) * D + lane * 4; const float* bp = args.in[I_LNB] + (LIDX) * D + lane * 4; f32x4 gv[4], bv[4]; \
        _Pragma("unroll") for (int j = 0; j < 4; ++j) { gv[j] = *(const GAS f32x4*)(gp + 256 * j); bv[j] = *(const GAS f32x4*)(bp + 256 * j); } \
        for (int m = gw; m < NTOK; m += 2 * NGW) { const int m2 = m + NGW; const bool two = m2 < NTOK; f32x4 va[4], vb[4]; LOADER(va, RES, BR, m); LOADER(vb, RES, BR, (two ? m2 : m)); \
            float mean_a, rstd_a, mean_b, rstd_b; LN_ROW_STATS(va, mean_a, rstd_a); LN_ROW_STATS(vb, mean_b, rstd_b); \
            LN_STORE_BF16(va, rstd_a, DST, m); if (two) LN_STORE_BF16(vb, rstd_b, DST, m2); } } while (0)
    if (IN(5)) { PHASE_IDS(); LN_PHASE(LN_LOAD_F32RES, x_in, Hb, X1, 0); if (BOTH(5)) GRID_BAR(); }

    if (IN(6)) {
        pg8::DenseSched S{(const char*)X1, (const char*)W_FFNIN, NTOK / 256, 2 * FFN / 256, G, bx, (size_t)256 * D * 2, (size_t)256 * D * 2, D / 64};
#if FFN_DOWN_FP8
        pg8::EpiSwiGLU8 E{(fp8*)FFNH, FFN, 1.0f};
        pg8::gemm_phase<pg8::EpiSwiGLU8, pg8::DenseSched, false>(lds + RING_OFF, D * 2, D * 2, S, E);
#else
        pg8::EpiSwiGLU E{FFNH, FFN};
        pg8::gemm_phase<pg8::EpiSwiGLU, pg8::DenseSched, false>(lds + RING_OFF, D * 2, D * 2, S, E);
#endif
        if (BOTH(6)) GRID_BAR();
    }
    if (IN(7)) {
#if FFN_DOWN_FP8
        pg8::DenseSched S{(const char*)FFNH, (const char*)W_FFNOUT, NTOK / 256, D / 256, G, bx, (size_t)256 * FFN, (size_t)256 * FFN, FFN / 128};
        pg8::EpiBf16S E{Hb, D, 1.0f / MOE_SC_OUT};
        pg8::gemm_phase<pg8::EpiBf16S, pg8::DenseSched, false, true>(lds + RING_OFF, FFN, FFN, S, E);
#else
        pg8::DenseSched S{(const char*)FFNH, (const char*)W_FFNOUT, NTOK / 256, D / 256, G, bx, (size_t)256 * FFN * 2, (size_t)256 * FFN * 2, FFN / 64};
        pg8::EpiBf16 E{Hb, D};
        pg8::gemm_phase<pg8::EpiBf16, pg8::DenseSched, false>(lds + RING_OFF, FFN * 2, FFN * 2, S, E);
#endif
        if (BOTH(7)) GRID_BAR();
    }
    if (IN(8)) { PHASE_IDS(); LN_PHASE(LN_LOAD_BF16RES, X1, Hb, X2, 1); if (BOTH(8)) GRID_BAR(); }

    if (IN(9)) {
        pg8::DenseSched S{(const char*)X2, (const char*)W_QKVA, NTOK / 256, QKVA_N / 256, G, bx, (size_t)256 * D * 2, (size_t)256 * D * 2, D / 64};
        if (G == (NTOK / 256) * (QKVA_N / 256)) {
            pg8::EpiQkvaPrep E{CQKV, KROPE, args.in[I_QNORM], args.in[I_KVNORM], ROPE_C, ROPE_S};
            pg8::gemm_phase<pg8::EpiQkvaPrep, pg8::DenseSched, false>(lds + RING_OFF, D * 2, D * 2, S, E);
        } else {
        pg8::EpiF32 E{QKVAF, QKVA_N};
        pg8::gemm_phase<pg8::EpiF32, pg8::DenseSched, false>(lds + RING_OFF, D * 2, D * 2, S, E);
        }
        if (BOTH(9)) GRID_BAR();
    }
    if (IN(10) && G != (NTOK / 256) * (QKVA_N / 256)) {
        PHASE_IDS();
        f32x4 g0 = {0.f, 0.f, 0.f, 0.f}, g1 = {0.f, 0.f, 0.f, 0.f};
        if (lane < 32) { g0 = *(const GAS f32x4*)(args.in[I_QNORM] + lane * 8); g1 = *(const GAS f32x4*)(args.in[I_QNORM] + lane * 8 + 4); }
        else if (lane < 48) { g0 = *(const GAS f32x4*)(args.in[I_KVNORM] + (lane - 32) * 8); g1 = *(const GAS f32x4*)(args.in[I_KVNORM] + (lane - 32) * 8 + 4); }
        for (int m = gw; m < NTOK; m += NGW) {
            const float* rp = QKVAF + (size_t)m * QKVA_N + lane * 8; const f32x4 a0 = *(const GAS f32x4*)(rp), a1 = *(const GAS f32x4*)(rp + 4);
            const float ss = (a0[0] * a0[0] + a0[1] * a0[1]) + (a0[2] * a0[2] + a0[3] * a0[3]) + (a1[0] * a1[0] + a1[1] * a1[1]) + (a1[2] * a1[2] + a1[3] * a1[3]);
            const float sq = wave_sum(lane < 32 ? ss : 0.f), skv = wave_sum((lane >= 32 && lane < 48) ? ss : 0.f);
            const float rq = 1.f / sqrtf(sq * (1.f / QL) + RMS_EPS), rkv = 1.f / sqrtf(skv * (1.f / KVL) + RMS_EPS);
            const int partner = (lane >= 48 && lane < 52) ? lane + 4 : ((lane >= 52 && lane < 56) ? lane - 4 : lane);
            f32x4 p0, p1;
#pragma unroll
            for (int e = 0; e < 4; ++e) { p0[e] = __shfl(a0[e], partner); p1[e] = __shfl(a1[e], partner); }
            if (lane < 48) { const float rs = lane < 32 ? rq : rkv; u32x4 w; w.x = cvt_pk_bf16(a0[0] * rs * g0[0], a0[1] * rs * g0[1]); w.y = cvt_pk_bf16(a0[2] * rs * g0[2], a0[3] * rs * g0[3]);
                w.z = cvt_pk_bf16(a1[0] * rs * g1[0], a1[1] * rs * g1[1]); w.w = cvt_pk_bf16(a1[2] * rs * g1[2], a1[3] * rs * g1[3]); *(GAS u32x4*)(CQKV + (size_t)m * QKVB_K + lane * 8) = w; }
            else if (lane < 56) { const int pos = m & (SEQ - 1), fi = ((lane - 48) & 3) * 8; const float* cp = ROPE_C + pos * 32 + fi; const float* sp = ROPE_S + pos * 32 + fi;
                const f32x4 c0 = *(const GAS f32x4*)(cp), c1 = *(const GAS f32x4*)(cp + 4), s0 = *(const GAS f32x4*)(sp), s1 = *(const GAS f32x4*)(sp + 4); f32x4 o0, o1;
                if (lane < 52) { o0 = a0 * c0 - p0 * s0; o1 = a1 * c1 - p1 * s1; }
                else { o0 = p0 * s0 + a0 * c0; o1 = p1 * s1 + a1 * c1; }
                u32x4 w; w.x = cvt_pk_bf16(o0[0], o0[1]); w.y = cvt_pk_bf16(o0[2], o0[3]); w.z = cvt_pk_bf16(o1[0], o1[1]); w.w = cvt_pk_bf16(o1[2], o1[3]);
                *(GAS u32x4*)(KROPE + (size_t)m * 64 + (lane - 48) * 8) = w; }
        }
        if (BOTH(10)) GRID_BAR();
    }
    if (IN(11)) {
#if MLA_ABSORB
        pg8::DenseSched S{(const char*)CQKV, (const char*)W_QKVB, NTOK / 256, QW / 256, G, bx, (size_t)256 * QKVB_K * 2, (size_t)256 * QL * 2, QL / 64};
        pg8::EpiBf16 E{QKV, QW};
        pg8::gemm_phase<pg8::EpiBf16, pg8::DenseSched, false>(lds + RING_OFF, QL * 2, QKVB_K * 2, S, E);
#else
        pg8::QkvbSched S{(const char*)CQKV, (const char*)W_QKVB, G, bx};
        pg8::EpiBf16 E{QKV, QKVB_N};
        pg8::gemm_phase<pg8::EpiBf16, pg8::QkvbSched, false>(lds + RING_OFF, QKVB_K * 2, QKVB_K * 2, S, E);
#endif
        if (BOTH(11)) GRID_BAR();
    }
    if (IN(12)) {
        att::Conv cv{args.in[I_MOEIN], (unsigned char*)W_MOEIN, 0, G, bx, 0, 0};
        for (int it = vcu; it < BATCH * HEADS * 4; it += G) {
            const int bh = it >> 2, xq = it & 3, b = bh >> 3, h = bh & 7;
            for (int pass = 0; pass < 2; ++pass) { const int qb = pass ? 7 - xq : xq; const size_t tok0 = (size_t)b * SEQ;
#if MLA_ABSORB
                att::attn_block<QW, QKVB_K>(QKV + (tok0 + qb * 256) * QW + h * (QKN + QKR), CQKV + tok0 * QKVB_K + QL, CQKV + tok0 * QKVB_K + QL,
                                KROPE + tok0 * 64, OB + (tok0 + qb * 256) * D + h * VD, qb * 256, ROPE_C, ROPE_S, (char*)lds_raw + RING_OFF, lds + RING_OFF, cv); }
#else
                att::attn_block<QKVB_N, QKVB_N>(QKV + (tok0 + qb * 256) * QKVB_N + h * (QKN + QKR), QKV + tok0 * QKVB_N + QW + h * (QKN + VD), QKV + tok0 * QKVB_N + QW + h * (QKN + VD) + QKN,
                                KROPE + tok0 * 64, OB + (tok0 + qb * 256) * D + h * VD, qb * 256, ROPE_C, ROPE_S, (char*)lds_raw + RING_OFF, lds + RING_OFF, cv); }
#endif
        }
        if (CONV_IN_ATTN) att::conv_drain(cv, lds + RING_OFF);
        __syncthreads();
        if (BOTH(12)) GRID_BAR();
    }
    if (IN(13)) {
        pg8::DenseSched S{(const char*)OB, (const char*)W_OW, NTOK / 256, D / 256, G, bx, (size_t)256 * D * 2, (size_t)256 * D * 2, D / 64};
        pg8::EpiBf16 E{H3b, D};
        pg8::gemm_phase<pg8::EpiBf16, pg8::DenseSched, false>(lds + RING_OFF, D * 2, D * 2, S, E);
        if (BOTH(13)) GRID_BAR();
    }
    if (IN(14)) {
        PHASE_IDS();
        LAS int* L_E = (LAS int*)(lds + RING_OFF);
        LAS int* L_CNT = L_E + 128;
        LAS int* L_BASE = L_CNT + 8;
        LAS int* L_RANK = L_BASE + 8;
        const float* gp = args.in[I_LNG] + 2 * D + lane * 4; const float* bp = args.in[I_LNB] + 2 * D + lane * 4; f32x4 gv[4], bv[4];
#pragma unroll
        for (int j = 0; j < 4; ++j) { gv[j] = *(const GAS f32x4*)(gp + 256 * j); bv[j] = *(const GAS f32x4*)(bp + 256 * j); }
        f32x4 rw[16][2];
#pragma unroll
        for (int j = 0; j < 4; ++j)
#pragma unroll
            for (int q = 0; q < 4; ++q) { const float* wk = args.in[I_ROUTER] + (size_t)(j * 256 + lane * 4 + q) * 8; rw[j * 4 + q][0] = *(const GAS f32x4*)(wk); rw[j * 4 + q][1] = *(const GAS f32x4*)(wk + 4); }
        for (int rb = bx; rb < NTOK / 128; rb += G) {
            if (tid < 8) L_CNT[tid] = 0;
            __syncthreads();
            for (int i = 0; i < 16; ++i) {
                const int m = rb * 128 + wave * 16 + i;
                f32x4 v[4]; LN_LOAD_BF16RES(v, X2, H3b, m);
                float mean, rstd; LN_ROW_STATS(v, mean, rstd);
                float lg[8];
#pragma unroll
                for (int e = 0; e < 8; ++e) lg[e] = 0.f;
                GAS u32x2* o8 = (GAS u32x2*)(X3 + (size_t)m * D) + lane;
#pragma unroll
                for (int j = 0; j < 4; ++j) { const f32x4 y = v[j] * rstd * gv[j] + bv[j]; u32x2 w; w.x = cvt_pk_bf16(y[0], y[1]); w.y = cvt_pk_bf16(y[2], y[3]); o8[64 * j] = w;
#if MOE_FP8
                    *((GAS unsigned*)(X3Q + (size_t)m * D) + 64 * j + lane) = pk4_fp8(y[0], y[1], y[2], y[3]);
#endif
#pragma unroll
                    for (int q = 0; q < 4; ++q) { const f32x4 w0 = rw[j * 4 + q][0], w1 = rw[j * 4 + q][1];
                        lg[0] += y[q] * w0[0]; lg[1] += y[q] * w0[1]; lg[2] += y[q] * w0[2]; lg[3] += y[q] * w0[3]; lg[4] += y[q] * w1[0]; lg[5] += y[q] * w1[1]; lg[6] += y[q] * w1[2]; lg[7] += y[q] * w1[3]; } }
#pragma unroll
                for (int e = 0; e < 8; ++e) lg[e] = wave_sum(lg[e]);
                int e0 = 0; float v0 = lg[0];
#pragma unroll
                for (int e = 1; e < 8; ++e) if (lg[e] > v0) { v0 = lg[e]; e0 = e; }
                int e1 = (e0 == 0) ? 1 : 0; float v1 = (e0 == 0) ? lg[1] : lg[0];
#pragma unroll
                for (int e = 1; e < 8; ++e) if (e != e0 && lg[e] > v1) { v1 = lg[e]; e1 = e; }
                const float ex = __expf(v1 - v0), g0 = 1.f / (1.f + ex), g1 = ex / (1.f + ex);
                if (lane == 0) { L_E[wave * 16 + i] = e0 | (e1 << 8); GATES[(size_t)m * 2] = g0; GATES[(size_t)m * 2 + 1] = g1; }
            }
            __syncthreads();
            if (tid < 128) { const int ee = L_E[tid]; L_RANK[2 * tid] = __hip_atomic_fetch_add(&L_CNT[ee & 255], 1, __ATOMIC_RELAXED, __HIP_MEMORY_SCOPE_WORKGROUP); L_RANK[2 * tid + 1] = __hip_atomic_fetch_add(&L_CNT[ee >> 8], 1, __ATOMIC_RELAXED, __HIP_MEMORY_SCOPE_WORKGROUP); }
            __syncthreads();
            if (tid < 8) L_BASE[tid] = (int)__hip_atomic_fetch_add((unsigned*)(ctl + CW_ECNT + 64 * tid), (unsigned)L_CNT[tid], RLX_AGENT);
            __syncthreads();
            if (tid < 128) { const int ee = L_E[tid], e0 = ee & 255, e1 = ee >> 8, m = rb * 128 + tid; const int p0 = L_BASE[e0] + L_RANK[2 * tid], p1 = L_BASE[e1] + L_RANK[2 * tid + 1];
                ROW_TOK[e0 * NTOK + p0] = m; ROW_TOK[e1 * NTOK + p1] = m; *(GAS i32x4*)(TOK_INFO + (size_t)m * 4) = (i32x4){e0, p0, e1, p1}; }
            __syncthreads();
        }
        if (BOTH(14)) GRID_BAR();
    }
    if (IN(15)) {
#if MOE_FP8
        pg8::MoeSched S; S.A = (const char*)X3Q; S.Bt = (const char*)W_MOEIN; S.row_tok = ROW_TOK; S.nN = 2 * EXD / 256; S.nt = D / 128; S.G = G; S.c = bx; S.astep = 0; S.bexp = (size_t)2 * EXD * D; S.bstep = (size_t)256 * D; S.rowb = D;
        S.init((const unsigned*)(ctl + CW_ECNT));
        pg8::EpiSwiGLU8 E{(fp8*)MOEH, EXD, 1.0f / MOE_SC_IN};
        pg8::gemm_phase<pg8::EpiSwiGLU8, pg8::MoeSched, true, true>(lds + RING_OFF, D, D, S, E);
#else
        pg8::MoeSched S; S.A = (const char*)X3; S.Bt = (const char*)W_MOEIN; S.row_tok = ROW_TOK; S.nN = 2 * EXD / 256; S.nt = D / 64; S.G = G; S.c = bx; S.astep = 0; S.bexp = (size_t)2 * EXD * D * 2; S.bstep = (size_t)256 * D * 2; S.rowb = D * 2;
        S.init((const unsigned*)(ctl + CW_ECNT));
        pg8::EpiSwiGLU E{MOEH, EXD};
        pg8::gemm_phase<pg8::EpiSwiGLU, pg8::MoeSched, true>(lds + RING_OFF, D * 2, D * 2, S, E);
#endif
        if (BOTH(15)) GRID_BAR();
    }
    if (IN(16)) {
#if MOE_FP8
        pg8::MoeDownSched S; S.A = (const char*)MOEH; S.Bt = (const char*)W_MOEOUT; S.row_tok = ROW_TOK; S.nN = D / 256; S.nt = EXD / 128; S.G = G; S.c = bx; S.astep = (size_t)256 * EXD; S.bexp = (size_t)D * EXD; S.bstep = (size_t)256 * EXD; S.rowb = 0;
        S.init((const unsigned*)(ctl + CW_ECNT)); S.init2();
        pg8::EpiMoeDown E{YB, YSLAB, S.T0, (S.ts[NEXP] - S.T0) * 256, 1.0f / MOE_SC_OUT};
        pg8::gemm_phase<pg8::EpiMoeDown, pg8::MoeDownSched, false, true>(lds + RING_OFF, EXD, EXD, S, E);
#else
        pg8::MoeSched S; S.A = (const char*)MOEH; S.Bt = (const char*)W_MOEOUT; S.row_tok = ROW_TOK; S.nN = D / 256; S.nt = EXD / 64; S.G = G; S.c = bx; S.astep = (size_t)256 * EXD * 2; S.bexp = (size_t)D * EXD * 2; S.bstep = (size_t)256 * EXD * 2; S.rowb = 0;
        S.init((const unsigned*)(ctl + CW_ECNT));
        pg8::EpiBf16 E{YB, D};
        pg8::gemm_phase<pg8::EpiBf16, pg8::MoeSched, false>(lds + RING_OFF, EXD * 2, EXD * 2, S, E);
#endif
        if (BOTH(16)) GRID_BAR();
    }
    if (IN(17)) {
        PHASE_IDS();
        int ts[NEXP]; { int t = 0;
#pragma unroll
            for (int e = 0; e < NEXP; ++e) { const int c = (int)__builtin_amdgcn_readfirstlane(__hip_atomic_load((const unsigned*)(ctl + CW_ECNT + 64 * e), __ATOMIC_RELAXED, __HIP_MEMORY_SCOPE_AGENT)); ts[e] = t; t += (c + 255) >> 8; } }
        const float* gp = args.in[I_LNG] + 3 * D + lane * 4; const float* bp = args.in[I_LNB] + 3 * D + lane * 4; f32x4 gv[4], bv[4];
#pragma unroll
        for (int j = 0; j < 4; ++j) { gv[j] = *(const GAS f32x4*)(gp + 256 * j); bv[j] = *(const GAS f32x4*)(bp + 256 * j); }
        int T0_ = 0, tailr_ = 0;
#if MOE_FP8
        { int tt = 0;
#pragma unroll
          for (int e = 0; e < NEXP; ++e) { const int c = (int)__builtin_amdgcn_readfirstlane(__hip_atomic_load((const unsigned*)(ctl + CW_ECNT + 64 * e), __ATOMIC_RELAXED, __HIP_MEMORY_SCOPE_AGENT)); tt += (c + 255) >> 8; }
          const int per = (G % 4 == 0) ? G / 4 : 1; T0_ = (tt / per) * per; tailr_ = (tt - T0_) * 256; }
#else
        T0_ = 1 << 30;
#endif
#define P17_YROW(yv, r_) do { const int r__ = (r_); if ((r__ >> 8) < T0_) { const GAS u32x2* yp = (const GAS u32x2*)(YB + (size_t)r__ * D) + lane; \
                _Pragma("unroll") for (int j = 0; j < 4; ++j) { const u32x2 ya = yp[64 * j]; yv[j] = (f32x4){bf_lo(ya.x), bf_hi(ya.x), bf_lo(ya.y), bf_hi(ya.y)}; } } \
            else { const GAS f32x4* sp_ = (const GAS f32x4*)(YSLAB + (size_t)(r__ - T0_ * 256) * D) + lane; _Pragma("unroll") for (int j = 0; j < 4; ++j) yv[j] = sp_[64 * j]; \
                for (int ks = 1; ks < pg8::MOE_KS; ++ks) { const GAS f32x4* sq_ = sp_ + (size_t)ks * tailr_ * (D / 4); _Pragma("unroll") for (int j = 0; j < 4; ++j) yv[j] += sq_[64 * j]; } } } while (0)
#define P17_LOAD(v, m_) do { const i32x4 ti = *(const GAS i32x4*)(TOK_INFO + (size_t)(m_) * 4); const float g0 = GATES[(size_t)(m_) * 2], g1 = GATES[(size_t)(m_) * 2 + 1]; int t0 = 0, t1 = 0; \
            _Pragma("unroll") for (int e = 0; e < NEXP; ++e) { t0 = (ti.x == e) ? ts[e] : t0; t1 = (ti.z == e) ? ts[e] : t1; } \
            const int r0_ = t0 * 256 + ti.y, r1_ = t1 * 256 + ti.w; const GAS u32x2* xr = (const GAS u32x2*)(X3 + (size_t)(m_) * D) + lane; \
            if ((r0_ >> 8) < T0_ && (r1_ >> 8) < T0_) {     \
                const GAS u32x2* y0 = (const GAS u32x2*)(YB + (size_t)r0_ * D) + lane; const GAS u32x2* y1 = (const GAS u32x2*)(YB + (size_t)r1_ * D) + lane; \
                _Pragma("unroll") for (int j = 0; j < 4; ++j) { const u32x2 xa = __builtin_nontemporal_load(xr + 64 * j), ya = __builtin_nontemporal_load(y0 + 64 * j), yb = __builtin_nontemporal_load(y1 + 64 * j); \
                    v[j][0] = ALPHA * bf_lo(xa.x) + (g0 * bf_lo(ya.x) + g1 * bf_lo(yb.x)); v[j][1] = ALPHA * bf_hi(xa.x) + (g0 * bf_hi(ya.x) + g1 * bf_hi(yb.x)); \
                    v[j][2] = ALPHA * bf_lo(xa.y) + (g0 * bf_lo(ya.y) + g1 * bf_lo(yb.y)); v[j][3] = ALPHA * bf_hi(xa.y) + (g0 * bf_hi(ya.y) + g1 * bf_hi(yb.y)); } } \
            else { f32x4 ya_[4], yb_[4]; P17_YROW(ya_, r0_); P17_YROW(yb_, r1_); \
                _Pragma("unroll") for (int j = 0; j < 4; ++j) { const u32x2 xa = xr[64 * j]; \
                    v[j][0] = ALPHA * bf_lo(xa.x) + (g0 * ya_[j][0] + g1 * yb_[j][0]); v[j][1] = ALPHA * bf_hi(xa.x) + (g0 * ya_[j][1] + g1 * yb_[j][1]); \
                    v[j][2] = ALPHA * bf_lo(xa.y) + (g0 * ya_[j][2] + g1 * yb_[j][2]); v[j][3] = ALPHA * bf_hi(xa.y) + (g0 * ya_[j][3] + g1 * yb_[j][3]); } } } while (0)
#define P17_STORE(v, rstd, m_) do { GAS f32x4* o = (GAS f32x4*)(args.out + (size_t)(m_) * D) + lane; _Pragma("unroll") for (int j = 0; j < 4; ++j) __builtin_nontemporal_store(v[j] * rstd * gv[j] + bv[j], o + 64 * j); } while (0)
        for (int m = gw; m < NTOK; m += 2 * NGW) { const int m2 = m + NGW; const bool two = m2 < NTOK;
            f32x4 va[4], vb[4]; P17_LOAD(va, m); P17_LOAD(vb, (two ? m2 : m));
            float mean_a, rstd_a, mean_b, rstd_b; LN_ROW_STATS(va, mean_a, rstd_a); LN_ROW_STATS(vb, mean_b, rstd_b);
            P17_STORE(va, rstd_a, m); if (two) P17_STORE(vb, rstd_b, m2);
        }
    }
#undef IN
#undef BOTH
}

extern "C" void kernel_launch(void* const* d_in, const int* in_sizes, int n_in, void* d_out, int out_size, void* d_ws, size_t ws_size, hipStream_t stream) {
    static int grid = 0;
    if (grid == 0) {
        if (n_in != 24 || in_sizes[0] != NTOK * D || out_size != NTOK * D || ws_size < WS_END) { fprintf(stderr, "kernel_launch: unexpected shapes (n_in %d, in0 %d, out %d, ws %zu < %zu); nothing launched\n", n_in, n_in > 0 ? in_sizes[0] : -1, out_size, ws_size, (size_t)WS_END); grid = -1; return; }
        int dev = 0, cus = 0, per_cu = 0;
        if (hipGetDevice(&dev) != hipSuccess || hipDeviceGetAttribute(&cus, hipDeviceAttributeMultiprocessorCount, dev) != hipSuccess) { grid = -1; return; }
        if (hipFuncSetAttribute((const void*)yoco_fwd, hipFuncAttributeMaxDynamicSharedMemorySize, LDS_BYTES) != hipSuccess) { fprintf(stderr, "kernel_launch: hipFuncSetAttribute failed\n"); grid = -1; return; }
        if (hipOccupancyMaxActiveBlocksPerMultiprocessor(&per_cu, (const void*)yoco_fwd, NWAVES * 64, LDS_BYTES) != hipSuccess || per_cu < 1) { fprintf(stderr, "kernel_launch: occupancy query reports %d blocks per CU\n", per_cu); }
        (void)hipGetLastError();
        grid = cus;
    }
    if (grid < 0) return;
    if (hipMemsetAsync((char*)d_ws + WS_CTL, 0, CTL_ZERO_BYTES, stream) != hipSuccess) return;
    Args a{};
    for (int i = 0; i < 24; ++i) a.in[i] = (const float*)d_in[i];
    a.out = (float*)d_out; a.ws = (unsigned char*)d_ws;
    constexpr int NPH = 18;
    if (MK_N_LAUNCHES == 1) { a.ph_lo = 0; a.ph_hi = NPH; a.li = 0; hipLaunchKernelGGL(yoco_fwd, dim3(grid), dim3(NWAVES * 64), LDS_BYTES, stream, a); }
    else { for (int p = 0; p < NPH; ++p) { a.ph_lo = p; a.ph_hi = p + 1; a.li = p; hipLaunchKernelGGL(yoco_fwd, dim3(grid), dim3(NWAVES * 64), LDS_BYTES, stream, a); } }
#ifdef PROBE_MASK
    for (int p = 0; p < NPH + 8; ++p) if ((PROBE_MASK >> p) & 1) { a.ph_lo = p; a.ph_hi = p + 1; a.li = 1; hipLaunchKernelGGL(yoco_fwd, dim3(grid), dim3(NWAVES * 64), LDS_BYTES, stream, a); }
#endif
}
```
